# Optimizing an MI355X kernel written in HIP

```python
import jax, jax.numpy as jnp
from jax import lax
import numpy as np

D_MODEL = 1024
BATCH = 8
SEQ = 2048
DEPTH = 1

CHUNK = 64
RET_HEADS = 8
RET_DQK = 64
RET_DV = 128
SB_HEADS = 8
SB_DH = 64
SB_BLOCK = 128
D_FF = 4 * D_MODEL
ROPE_BASE = 10000.0
EPS = 1e-6

RET_QK = RET_HEADS * RET_DQK
RET_V = RET_HEADS * RET_DV
SB_W = SB_HEADS * SB_DH
IN_SPLITS = (RET_QK, RET_QK, RET_V, RET_V, SB_W, SB_W, SB_W, D_MODEL, D_MODEL)
D_IN = 2 * RET_QK + 2 * RET_V + 3 * SB_W + 2 * D_MODEL

kernel_name = "hybrid_retention_stickbreaking_block"


def rmsnorm(x, g):
    xf = x.astype(jnp.float32)
    y = xf * lax.rsqrt(jnp.mean(xf * xf, axis=-1, keepdims=True) + EPS)
    return y * g


def modulate(h, shift, scale):
    return h * (1.0 + scale[:, None, :]) + shift[:, None, :]


def rotary(x, pos):
    d = x.shape[-1]
    inv_freq = ROPE_BASE ** (-jnp.arange(0, d, 2, dtype=jnp.float32) / d)
    ang = pos.astype(jnp.float32)[..., None] * inv_freq
    cos = jnp.cos(ang)[:, :, None, :]
    sin = jnp.sin(ang)[:, :, None, :]
    x1, x2 = x[..., : d // 2], x[..., d // 2:]
    return jnp.concatenate([x1 * cos - x2 * sin, x1 * sin + x2 * cos], axis=-1)


def retention(q, k, v, pos):
    B, S = q.shape[0], q.shape[1]
    nc = S // CHUNK
    q = rotary(q.astype(jnp.float32), pos)
    k = rotary(k.astype(jnp.float32), pos) * (RET_DQK ** -0.5)
    v = v.astype(jnp.float32)
    log_gamma = jnp.log1p(-(2.0 ** (-5.0 - jnp.arange(RET_HEADS, dtype=jnp.float32))))
    qc = q.reshape(B, nc, CHUNK, RET_HEADS, RET_DQK)
    kc = k.reshape(B, nc, CHUNK, RET_HEADS, RET_DQK)
    vc = v.reshape(B, nc, CHUNK, RET_HEADS, RET_DV)
    idx = jnp.arange(CHUNK, dtype=jnp.float32)
    intra_decay = jnp.exp(jnp.abs(idx[:, None] - idx[None, :])[None] * log_gamma[:, None, None])
    scores = jnp.einsum('bnihd,bnjhd->bnhij', qc, kc) * intra_decay
    intra = jnp.einsum('bnhij,bnjhe->bnihe', scores, vc)
    k_to_end = jnp.exp((CHUNK - 1.0 - idx)[:, None] * log_gamma[None, :])
    kv = jnp.einsum('bnjhd,jh,bnjhe->nbhde', kc, k_to_end, vc)
    chunk_decay = jnp.exp(CHUNK * log_gamma)[None, :, None, None]

    def step(state, kv_n):
        return state * chunk_decay + kv_n, state

    _, s_prev = lax.scan(step, jnp.zeros(kv.shape[1:], jnp.float32), kv)
    q_from_start = jnp.exp((idx + 1.0)[:, None] * log_gamma[None, :])
    cross = jnp.einsum('bnihd,ih,nbhde->bnihe', qc, q_from_start, s_prev)
    return (intra + cross).reshape(B, S, RET_HEADS, RET_DV)


def stick_breaking(q, k, v):
    S = q.shape[1]
    scale = SB_DH ** -0.5
    q = q.astype(jnp.float32)
    k = k.astype(jnp.float32)
    v = v.astype(jnp.float32)
    outs = []
    for blk in range(S // SB_BLOCK):
        t0 = blk * SB_BLOCK
        t1 = t0 + SB_BLOCK
        z = jnp.einsum('bthd,bshd->bhts', q[:, t0:t1], k[:, :t1]) * scale
        t_idx = t0 + jnp.arange(SB_BLOCK)
        s_idx = jnp.arange(t1)
        valid = s_idx[None, :] < t_idx[:, None]
        log_1m = jnp.where(valid, -jax.nn.softplus(z), 0.0)
        log_stick = lax.cumsum(log_1m, axis=3, reverse=True) - log_1m
        a = jnp.where(valid, jnp.exp(jax.nn.log_sigmoid(z) + log_stick), 0.0)
        outs.append(jnp.einsum('bhts,bshd->bthd', a, v[:, :t1]))
    return jnp.concatenate(outs, axis=1)


def setup_inputs(seed: int = 0) -> dict:
    key = jax.random.key(seed)
    ks = jax.random.split(key, 18)
    nrm = jax.random.normal
    f32 = jnp.float32
    x = nrm(ks[0], (BATCH, SEQ, D_MODEL), f32)
    c = nrm(ks[1], (BATCH, D_MODEL), f32)
    offset = jax.random.randint(ks[2], (BATCH, 1), 0, 256, dtype=jnp.int32) * CHUNK
    positions = (offset + jnp.arange(SEQ, dtype=jnp.int32)[None, :]).astype(jnp.int32)
    ada_w = nrm(ks[3], (DEPTH, D_MODEL, 6 * D_MODEL), f32) * D_MODEL ** -0.5
    ada_b = 0.01 * nrm(ks[4], (DEPTH, 6 * D_MODEL), f32)
    pre_mix_g = 1.0 + 0.02 * nrm(ks[5], (DEPTH, D_MODEL), f32)
    post_mix_g = 1.0 + 0.02 * nrm(ks[6], (DEPTH, D_MODEL), f32)
    pre_ffn_g = 1.0 + 0.02 * nrm(ks[7], (DEPTH, D_MODEL), f32)
    post_ffn_g = 1.0 + 0.02 * nrm(ks[8], (DEPTH, D_MODEL), f32)
    w_in = nrm(ks[9], (DEPTH, D_MODEL, D_IN), f32) * D_MODEL ** -0.5
    ret_gn_g = 1.0 + 0.02 * nrm(ks[10], (DEPTH, RET_V), f32)
    w_ret_branch = nrm(ks[11], (DEPTH, RET_V, D_MODEL), f32) * RET_V ** -0.5
    w_sb_branch = nrm(ks[12], (DEPTH, SB_W, D_MODEL), f32) * SB_W ** -0.5
    w_out = nrm(ks[13], (DEPTH, D_MODEL, D_MODEL), f32) * D_MODEL ** -0.5
    w_ff1 = nrm(ks[14], (DEPTH, D_MODEL, D_FF), f32) * D_MODEL ** -0.5
    w_ff2 = nrm(ks[15], (DEPTH, D_FF, D_MODEL), f32) * D_FF ** -0.5
    return {"x": x, "c": c, "positions": positions, "ada_w": ada_w, "ada_b": ada_b,
            "pre_mix_g": pre_mix_g, "post_mix_g": post_mix_g, "pre_ffn_g": pre_ffn_g,
            "post_ffn_g": post_ffn_g, "w_in": w_in, "ret_gn_g": ret_gn_g,
            "w_ret_branch": w_ret_branch, "w_sb_branch": w_sb_branch, "w_out": w_out,
            "w_ff1": w_ff1, "w_ff2": w_ff2}


def reference(x, c, positions, ada_w, ada_b, pre_mix_g, post_mix_g, pre_ffn_g, post_ffn_g,
              w_in, ret_gn_g, w_ret_branch, w_sb_branch, w_out, w_ff1, w_ff2):
    out_dtype = x.dtype
    B, S, _ = x.shape
    split_pts = [int(p) for p in np.cumsum(IN_SPLITS)[:-1]]
    h_res = x.astype(jnp.float32)
    for l in range(DEPTH):
        mod = jax.nn.silu(c.astype(jnp.float32)) @ ada_w[l] + ada_b[l]
        sh1, sc1, gt1, sh2, sc2, gt2 = jnp.split(mod, 6, axis=-1)

        h = modulate(rmsnorm(h_res, pre_mix_g[l]), sh1, sc1)
        proj = h @ w_in[l]
        q_r, k_r, v_r, g_r, q_s, k_s, v_s, a_r, a_s = jnp.split(proj, split_pts, axis=-1)

        ret = retention(q_r.reshape(B, S, RET_HEADS, RET_DQK),
                        k_r.reshape(B, S, RET_HEADS, RET_DQK),
                        v_r.reshape(B, S, RET_HEADS, RET_DV), positions)
        mu = jnp.mean(ret, axis=-1, keepdims=True)
        var = jnp.mean(jnp.square(ret - mu), axis=-1, keepdims=True)
        ret = (ret - mu) * lax.rsqrt(var + EPS) * ret_gn_g[l].reshape(RET_HEADS, RET_DV)
        ret = jax.nn.silu(g_r) * ret.reshape(B, S, RET_V)

        sb = stick_breaking(q_s.reshape(B, S, SB_HEADS, SB_DH),
                            k_s.reshape(B, S, SB_HEADS, SB_DH),
                            v_s.reshape(B, S, SB_HEADS, SB_DH)).reshape(B, S, SB_W)

        mixed = (jax.nn.sigmoid(a_r) * (ret @ w_ret_branch[l])
                 + jax.nn.sigmoid(a_s) * (sb @ w_sb_branch[l]))
        y = mixed @ w_out[l]
        h_res = h_res + gt1[:, None, :] * rmsnorm(y, post_mix_g[l])

        h2 = modulate(rmsnorm(h_res, pre_ffn_g[l]), sh2, sc2)
        f = jnp.square(jax.nn.relu(h2 @ w_ff1[l])) @ w_ff2[l]
        h_res = h_res + gt2[:, None, :] * rmsnorm(f, post_ffn_g[l])
    return h_res.astype(out_dtype)
```

```cpp
#include <hip/hip_runtime.h>
#include <cstdio>
#include <cstdint>
#include <cmath>
#define MK_N_LAUNCHES 1
namespace pg8 {
#define PG8_LAS __attribute__((address_space(3)))
typedef unsigned short bf16_t;
typedef short bf16x8 __attribute__((ext_vector_type(8)));
typedef float f32x4 __attribute__((ext_vector_type(4)));
typedef unsigned u32x4 __attribute__((ext_vector_type(4)));
constexpr int BM = 256, BK = 64, HALF = 128, HTB = HALF * BK * 2  , STAGE_BYTES = 8 * HTB, NXCD = 8, WGM = 8;

__host__ __device__ __forceinline__ int lds_byte(int r, int c) { const int st = (r >> 4) * 2 + (c >> 5), rr = r & 15, cc = c & 31, ob = rr * 64 + cc * 2; return st * 1024 + (ob ^ (((ob >> 9) & 1) << 5)); }
__host__ __device__ __forceinline__ void stage_rc(int b, int& R, int& C) { const int st = b / 1024, sb = b % 1024, swz = sb ^ (((sb >> 9) & 1) << 5); R = (st >> 1) * 16 + swz / 64; C = (st & 1) * 32 + (swz % 64) / 2; }
__host__ __device__ __forceinline__ int perm32(int rho) { const int n = rho >> 4, i = rho & 15; return 8 * (i >> 2) + 4 * n + (i & 3); }

struct Unit { int pm, pn; };
struct Gemm { const bf16_t* A; const bf16_t* Bt; int M, N, K; };

struct StaticOrder {
    int nM, nN, nwg, G, c;
    __host__ __device__ void init(int M, int N, int G_, int c_) { nM = M / BM; nN = N / BM; nwg = nM * nN; G = G_; c = c_; }
    __host__ __device__ bool next(int i, Unit& u) const {
        const long L = (long)i * G + c; if (L >= nwg) return false;
        int wgid = (int)L; { const int q = nwg / NXCD, r = nwg % NXCD, xcd = wgid % NXCD, off = wgid / NXCD; wgid = (xcd < r ? xcd * (q + 1) : r * (q + 1) + (xcd - r) * q) + off; }
        const int nig = WGM * nN, gid = wgid / nig, fm = gid * WGM, gsz = (nM - fm) < WGM ? (nM - fm) : WGM;
        u.pm = fm + ((wgid % nig) % gsz); u.pn = (wgid % nig) / gsz; return true;
    }
    __device__ __forceinline__ void a_ready(const Unit&) const {}
    __device__ __forceinline__ void done(const Unit&) const {}
};

__device__ __forceinline__ unsigned cvt_pk_bf16(float lo, float hi) { unsigned r; asm volatile("s_nop 0\n\tv_cvt_pk_bf16_f32 %0, %1, %2" : "=v"(r) : "v"(lo), "v"(hi)); return r; }
typedef float f32x2 __attribute__((ext_vector_type(2)));
constexpr int MTOKc = 16384;
constexpr float QS_SCALE = 0.125f * 1.4426950408889634f;
__device__ __forceinline__ float fsigmoid(float x) { return __builtin_amdgcn_rcpf(1.0f + __builtin_amdgcn_exp2f(-1.4426950408889634f * x)); }
__device__ __forceinline__ float bflo(unsigned w) { return __builtin_bit_cast(float, w << 16); }
__device__ __forceinline__ float bfhi(unsigned w) { return __builtin_bit_cast(float, w & 0xffff0000u); }
__device__ __forceinline__ void st8(bf16_t* p, const f32x4& a, const f32x4& b) {
    u32x4 w; w.x = cvt_pk_bf16(a[0], a[1]); w.y = cvt_pk_bf16(a[2], a[3]); w.z = cvt_pk_bf16(b[0], b[1]); w.w = cvt_pk_bf16(b[2], b[3]);
    *(u32x4*)p = w;
}
__device__ __forceinline__ float log2gamma(int h) { return __builtin_amdgcn_logf(1.0f - __builtin_amdgcn_exp2f((float)(-5 - h))); }

struct EpiProjNat {
    static constexpr bool PERM = true, AFTER_DRAIN = false;
    bf16_t *QR, *KR, *QS, *KS, *GR, *AR, *AS; const float* cs;
    template <int MODE> __device__ __forceinline__ void body(const f32x4 (&acc)[2][2][4][2], bf16_t* base, int ldc, int row0, int col0) const {
#pragma unroll
        for (int ai = 0; ai < 2; ++ai)
#pragma unroll
            for (int m = 0; m < 4; ++m) {
                const int row = row0 + ai * HALF + m * 16;
                bf16_t* rowp = base + (size_t)row * ldc + col0;
#pragma unroll
                for (int bj = 0; bj < 2; ++bj) {
                    f32x4 v0 = acc[ai][bj][m][0], v1 = acc[ai][bj][m][1];
                    if (MODE == 0 || MODE == 1) {
                        const int i0 = (col0 & 63) >> 1;
                        const f32x4 c01 = *(const f32x4*)(cs + ((size_t)row * 32 + i0) * 2);
                        const f32x4 c23 = *(const f32x4*)(cs + ((size_t)row * 32 + i0 + 2) * 2);
                        const float sc = (MODE == 1) ? 0.125f : 1.0f;
                        f32x4 o0, o1;
                        o0[0] = (v0[0] * c01[0] - v0[1] * c01[1]) * sc; o0[1] = (v0[0] * c01[1] + v0[1] * c01[0]) * sc;
                        o0[2] = (v0[2] * c01[2] - v0[3] * c01[3]) * sc; o0[3] = (v0[2] * c01[3] + v0[3] * c01[2]) * sc;
                        o1[0] = (v1[0] * c23[0] - v1[1] * c23[1]) * sc; o1[1] = (v1[0] * c23[1] + v1[1] * c23[0]) * sc;
                        o1[2] = (v1[2] * c23[2] - v1[3] * c23[3]) * sc; o1[3] = (v1[2] * c23[3] + v1[3] * c23[2]) * sc;
                        v0 = o0; v1 = o1;
                    } else if (MODE == 2) { v0 = v0 * QS_SCALE; v1 = v1 * QS_SCALE; }
                    else if (MODE == 4) {
#pragma unroll
                        for (int q = 0; q < 4; ++q) { v0[q] = v0[q] * fsigmoid(v0[q]); v1[q] = v1[q] * fsigmoid(v1[q]); }
                    } else if (MODE == 5) {
#pragma unroll
                        for (int q = 0; q < 4; ++q) { v0[q] = fsigmoid(v0[q]); v1[q] = fsigmoid(v1[q]); }
                    }
                    st8(rowp + bj * HALF, v0, v1);
                }
            }
    }
    __device__ __forceinline__ void operator()(const f32x4 (&acc)[2][2][4][2], const Unit& u, int wr, int wc, int fr, int fq) const {
        const int pn = u.pn, row0 = u.pm * BM + wr * 64 + fr, cw = wc * 32 + 8 * fq;
#ifdef PLAIN_NAT
        if (pn < 2)       body<3>(acc, QR, 512, row0, pn * BM + cw);
        else if (pn < 4)  body<3>(acc, KR, 512, row0, (pn - 2) * BM + cw);
        else if (pn < 6)  body<3>(acc, QS, 512, row0, (pn - 4) * BM + cw);
        else if (pn < 8)  body<3>(acc, KS, 512, row0, (pn - 6) * BM + cw);
        else if (pn < 12) body<3>(acc, GR, 1024, row0, (pn - 8) * BM + cw);
        else if (pn < 16) body<3>(acc, AR, 1024, row0, (pn - 12) * BM + cw);
        else              body<3>(acc, AS, 1024, row0, (pn - 16) * BM + cw);
        return;
#endif
        if (pn < 2)       body<0>(acc, QR, 512, row0, pn * BM + cw);
        else if (pn < 4)  body<1>(acc, KR, 512, row0, (pn - 2) * BM + cw);
        else if (pn < 6)  body<2>(acc, QS, 512, row0, (pn - 4) * BM + cw);
        else if (pn < 8)  body<3>(acc, KS, 512, row0, (pn - 6) * BM + cw);
        else if (pn < 12) body<4>(acc, GR, 1024, row0, (pn - 8) * BM + cw);
        else if (pn < 16) body<5>(acc, AR, 1024, row0, (pn - 12) * BM + cw);
        else              body<5>(acc, AS, 1024, row0, (pn - 16) * BM + cw);
    }
};

struct EpiProjTr {
    static constexpr bool PERM = true, AFTER_DRAIN = false;
    bf16_t *KRT, *VRT, *VST; const float* csT;
    __device__ __forceinline__ void operator()(const f32x4 (&acc)[2][2][4][2], const Unit& u, int wr, int wc, int fr, int fq) const {
        const int pm = u.pm, rf0 = pm * BM + wr * 64 + fr, tok0 = u.pn * BM + wc * 32 + 8 * fq;
#ifdef PLAIN_TR
        const bool rotp = false;
#else
        const bool rotp = pm < 2;
#endif
        if (rotp) {
#pragma unroll
            for (int ai = 0; ai < 2; ++ai)
#pragma unroll
                for (int m = 0; m < 4; ++m) {
                    const int rf = rf0 + ai * HALF + m * 16, h = rf >> 6, i = (rf & 63) >> 1;
                    const float sgn = (rf & 1) ? 1.0f : -1.0f, lg = log2gamma(h);
#pragma unroll
                    for (int bj = 0; bj < 2; ++bj) {
                        const int tok = tok0 + bj * HALF;
                        const f32x4 v0 = acc[ai][bj][m][0], v1 = acc[ai][bj][m][1];
                        const float* cp = csT + ((size_t)i * MTOKc + tok) * 2;
                        const f32x4 c0 = *(const f32x4*)(cp), c1 = *(const f32x4*)(cp + 4), c2 = *(const f32x4*)(cp + 8), c3 = *(const f32x4*)(cp + 12);
                        const float own[8] = {v0[0], v0[1], v0[2], v0[3], v1[0], v1[1], v1[2], v1[3]};
                        const float cc[8] = {c0[0], c0[2], c1[0], c1[2], c2[0], c2[2], c3[0], c3[2]};
                        const float ss[8] = {c0[1], c0[3], c1[1], c1[3], c2[1], c2[3], c3[1], c3[3]};
                        float o[8];
#pragma unroll
                        for (int q = 0; q < 8; ++q) {
                            const float oth = __shfl_xor(own[q], 1);
                            const float dec = 0.125f * __builtin_amdgcn_exp2f(lg * (float)(63 - ((tok & 63) + q)));
                            o[q] = (own[q] * cc[q] + sgn * oth * ss[q]) * dec;
                        }
                        st8(KRT + (size_t)rf * MTOKc + tok, (f32x4){o[0], o[1], o[2], o[3]}, (f32x4){o[4], o[5], o[6], o[7]});
                    }
                }
        } else {
            bf16_t* base = (pm < 2) ? KRT : (pm < 6) ? (VRT - (size_t)512 * MTOKc) : (VST - (size_t)1536 * MTOKc);
#pragma unroll
            for (int ai = 0; ai < 2; ++ai)
#pragma unroll
                for (int m = 0; m < 4; ++m) {
                    const int rf = rf0 + ai * HALF + m * 16;
#pragma unroll
                    for (int bj = 0; bj < 2; ++bj) st8(base + (size_t)rf * MTOKc + tok0 + bj * HALF, acc[ai][bj][m][0], acc[ai][bj][m][1]);
                }
        }
    }
};

template <bool SECOND> struct EpiMerge {
    static constexpr bool PERM = true, AFTER_DRAIN = false;
    const bf16_t* G; const bf16_t* T; bf16_t* O;
    __device__ __forceinline__ void operator()(const f32x4 (&acc)[2][2][4][2], const Unit& u, int wr, int wc, int fr, int fq) const {
        const int row0 = u.pm * BM + wr * 64 + fr, col0 = u.pn * BM + wc * 32 + 8 * fq;
#pragma unroll
        for (int ai = 0; ai < 2; ++ai)
#pragma unroll
            for (int m = 0; m < 4; ++m) {
                const size_t off = (size_t)(row0 + ai * HALF + m * 16) * 1024 + col0;
#pragma unroll
                for (int bj = 0; bj < 2; ++bj) {
                    const u32x4 g = *(const u32x4*)(G + off + bj * HALF);
                    f32x4 v0 = acc[ai][bj][m][0], v1 = acc[ai][bj][m][1];
                    v0[0] *= bflo(g.x); v0[1] *= bfhi(g.x); v0[2] *= bflo(g.y); v0[3] *= bfhi(g.y);
                    v1[0] *= bflo(g.z); v1[1] *= bfhi(g.z); v1[2] *= bflo(g.w); v1[3] *= bfhi(g.w);
                    if (SECOND) {
                        const u32x4 t = *(const u32x4*)(T + off + bj * HALF);
                        v0[0] += bflo(t.x); v0[1] += bfhi(t.x); v0[2] += bflo(t.y); v0[3] += bfhi(t.y);
                        v1[0] += bflo(t.z); v1[1] += bfhi(t.z); v1[2] += bflo(t.w); v1[3] += bfhi(t.w);
                    }
                    st8(O + off + bj * HALF, v0, v1);
                }
            }
    }
};

struct EpiF32 {
    static constexpr bool PERM = false, AFTER_DRAIN = false;
    float* O; int ldc;
    __device__ __forceinline__ void operator()(const f32x4 (&acc)[2][2][4][2], const Unit& u, int wr, int wc, int fr, int fq) const {
        const int row0 = u.pm * BM + wr * 64 + fr, col0 = u.pn * BM + wc * 32 + 4 * fq;
#pragma unroll
        for (int ai = 0; ai < 2; ++ai)
#pragma unroll
            for (int m = 0; m < 4; ++m) {
                float* rowp = O + (size_t)(row0 + ai * HALF + m * 16) * ldc + col0;
#pragma unroll
                for (int bj = 0; bj < 2; ++bj)
#pragma unroll
                    for (int n = 0; n < 2; ++n) *(f32x4*)(rowp + bj * HALF + n * 16) = acc[ai][bj][m][n];
            }
    }
};

template <int ACT  > struct EpiBf {
    static constexpr bool PERM = true, AFTER_DRAIN = false;
    bf16_t* O; int ldc;
    __device__ __forceinline__ void operator()(const f32x4 (&acc)[2][2][4][2], const Unit& u, int wr, int wc, int fr, int fq) const {
        const int row0 = u.pm * BM + wr * 64 + fr, col0 = u.pn * BM + wc * 32 + 8 * fq;
#pragma unroll
        for (int ai = 0; ai < 2; ++ai)
#pragma unroll
            for (int m = 0; m < 4; ++m) {
                bf16_t* rowp = O + (size_t)(row0 + ai * HALF + m * 16) * ldc + col0;
#pragma unroll
                for (int bj = 0; bj < 2; ++bj) {
                    f32x4 v0 = acc[ai][bj][m][0], v1 = acc[ai][bj][m][1];
                    if (ACT == 1) {
#pragma unroll
                        for (int q = 0; q < 4; ++q) { const float a = __builtin_fmaxf(v0[q], 0.f), b = __builtin_fmaxf(v1[q], 0.f); v0[q] = a * a; v1[q] = b * b; }
                    }
                    st8(rowp + bj * HALF, v0, v1);
                }
            }
    }
};
struct PanelStats {
    unsigned* xbuf;
    unsigned* cnt;
    unsigned* tmo;
    int ntn; float eps;
    unsigned code;
    __device__ __forceinline__ bool run(const f32x4 (&v)[2][2][4][2], const Unit& u, int wr, int wc, int fr, int fq, PG8_LAS unsigned char* lds, int wid, int lane) const {
        typedef float f32x2v __attribute__((ext_vector_type(2)));
        PG8_LAS f32x2v* P = (PG8_LAS f32x2v*)lds;
        PG8_LAS f32x2v* S = (PG8_LAS f32x2v*)(lds + 8192);
        PG8_LAS unsigned* flag = (PG8_LAS unsigned*)(lds + 8192 + 2048);
#pragma unroll
        for (int ai = 0; ai < 2; ++ai)
#pragma unroll
            for (int m = 0; m < 4; ++m) {
                float s = 0.f;
#pragma unroll
                for (int bj = 0; bj < 2; ++bj)
#pragma unroll
                    for (int n = 0; n < 2; ++n) { const f32x4 x = v[ai][bj][m][n]; s += (x[0] + x[1]) + (x[2] + x[3]); }
                s += __shfl_xor(s, 16); s += __shfl_xor(s, 32);
                const float mw = s * (1.0f / 64.0f); float q = 0.f;
#pragma unroll
                for (int bj = 0; bj < 2; ++bj)
#pragma unroll
                    for (int n = 0; n < 2; ++n) { const f32x4 d = v[ai][bj][m][n] - mw; q += (d[0] * d[0] + d[1] * d[1]) + (d[2] * d[2] + d[3] * d[3]); }
                q += __shfl_xor(q, 16); q += __shfl_xor(q, 32);
                if (fq == 0) P[(ai * HALF + wr * 64 + m * 16 + fr) * 4 + wc] = (f32x2v){mw, q};
            }
        asm volatile("s_waitcnt lgkmcnt(0)" ::: "memory"); __builtin_amdgcn_s_barrier(); asm volatile("" ::: "memory");
#if defined(BROKEN_EXCHANGE_NO_WAIT)
#warning BROKEN CONTROL BUILD: the row-statistics exchange does not wait; results are wrong by design
        if (blockIdx.x >= 64) { const long long t0_ = clock64(); while (clock64() - t0_ < 60000) __builtin_amdgcn_s_sleep(8); }
#endif
        const int row = wid * 32 + (lane & 31);
        if (lane < 32) {
            const f32x2v a = P[row * 4 + 0], b = P[row * 4 + 1], c = P[row * 4 + 2], d = P[row * 4 + 3];
            const float mt = (a.x + b.x + c.x + d.x) * 0.25f;
            const float da = a.x - mt, db = b.x - mt, dc = c.x - mt, dd = d.x - mt;
            const float m2 = (a.y + b.y) + (c.y + d.y) + 64.0f * ((da * da + db * db) + (dc * dc + dd * dd));
            unsigned long long* slot = (unsigned long long*)xbuf + ((size_t)(u.pm * BM + row) * 4 + u.pn);
            __hip_atomic_store(slot, ((unsigned long long)__float_as_uint(m2) << 32) | __float_as_uint(mt), __ATOMIC_RELAXED, __HIP_MEMORY_SCOPE_AGENT);
        }
        asm volatile("s_waitcnt vmcnt(0)" ::: "memory");
        if (lane == 0) __hip_atomic_fetch_add(cnt + 64 * u.pm, 1u, __ATOMIC_RELAXED, __HIP_MEMORY_SCOPE_AGENT);
        if (wid == 0) {
            bool dead = false; const unsigned long long t0 = __builtin_amdgcn_s_memrealtime(); const unsigned want = 8u * (unsigned)ntn;
            for (;;) {
#if defined(BROKEN_EXCHANGE_NO_WAIT)
                break;
#endif
                if ((unsigned)__builtin_amdgcn_readfirstlane(__hip_atomic_load(cnt + 64 * u.pm, __ATOMIC_RELAXED, __HIP_MEMORY_SCOPE_AGENT)) >= want) break;
                if (__builtin_amdgcn_s_memrealtime() - t0 > 2000000ull) {
                    if (lane == 0) { unsigned expect = 0u; __hip_atomic_compare_exchange_strong(tmo + 1, &expect, code | (unsigned)(u.pm & 0xff), __ATOMIC_RELAXED, __ATOMIC_RELAXED, __HIP_MEMORY_SCOPE_AGENT);
                                     __hip_atomic_store(tmo, 1u, __ATOMIC_RELAXED, __HIP_MEMORY_SCOPE_AGENT); }
                    dead = true; break; }
                __builtin_amdgcn_s_sleep(2);
            }
            __builtin_amdgcn_fence(__ATOMIC_ACQUIRE, "agent");
            if (lane == 0) flag[0] = dead ? 1u : 0u;
        }
        asm volatile("s_waitcnt vmcnt(0) lgkmcnt(0)" ::: "memory"); __builtin_amdgcn_s_barrier(); asm volatile("" ::: "memory");
        const bool bad = flag[0] != 0u;
        if (lane < 32) {
            const unsigned long long* slot = (const unsigned long long*)xbuf + (size_t)(u.pm * BM + row) * 4; float mt[4], m2[4]; float ms = 0.f;
#pragma unroll
            for (int t = 0; t < 4; ++t) { if (t < ntn) { const unsigned long long w = __hip_atomic_load(slot + t, __ATOMIC_RELAXED, __HIP_MEMORY_SCOPE_AGENT); mt[t] = __uint_as_float((unsigned)w); m2[t] = __uint_as_float((unsigned)(w >> 32)); } else { mt[t] = 0.f; m2[t] = 0.f; } ms += mt[t]; }
            const float mean = ms / (float)ntn; float q = 0.f;
#pragma unroll
            for (int t = 0; t < 4; ++t) if (t < ntn) { const float dm = mt[t] - mean; q += m2[t] + 256.0f * dm * dm; }
            S[row] = (f32x2v){mean, 1.0f / sqrtf(q / (256.0f * (float)ntn) + eps)};
        }
        asm volatile("s_waitcnt lgkmcnt(0)" ::: "memory"); __builtin_amdgcn_s_barrier(); asm volatile("" ::: "memory");
        return bad;
    }
};
template <class Epi, class Sched, bool ALIGN_EPI = false, bool SP2 = false>
__device__ __forceinline__ void gemm_phase(PG8_LAS unsigned char* lds, const Gemm g, const Sched& S, const Epi& E) {
    const int tid = threadIdx.x, wid = __builtin_amdgcn_readfirstlane(tid >> 6), lane = tid & 63, wr = wid >> 2, wc = wid & 3, fr = lane & 15, fq = lane >> 4;
    const int K = g.K, nt = K / BK;
    unsigned voffA[2], voffB[2];
#pragma unroll
    for (int i = 0; i < 2; ++i) { int R, C; stage_rc(tid * 16 + i * 8192, R, C); const int Rb = Epi::PERM ? ((R & ~31) + perm32(R & 31)) : R;
        voffA[i] = (unsigned)(R * K + C) * 2u; voffB[i] = (unsigned)(Rb * K + C) * 2u; }
    const size_t kstep = (size_t)(BK * 2);
    const size_t hstep = (size_t)HALF * K * 2;
    const size_t tstep = 2 * hstep;
    const unsigned ldsw = (unsigned)wid * 1024u;
    const int aoff = lds_byte(wr * 64 + fr, fq * 8), boff = lds_byte(wc * 32 + fr, fq * 8);
#define PG8_SA(b, h) (((b) * 2 + (h)) * HTB)
#define PG8_SB(b, h) ((4 + (b) * 2 + (h)) * HTB)
#define PG8_STAGE(bufoff, gbase, voff) do { _Pragma("unroll") for (int _i = 0; _i < 2; ++_i) \
        __builtin_amdgcn_global_load_lds((const unsigned*)((const char*)(gbase) + (voff)[_i]), (PG8_LAS unsigned*)(lds + (bufoff) + ldsw + _i * 8192), 16, 0, 0); } while (0)
#define PG8_LDA(dst, b, h) do { _Pragma("unroll") for (int m = 0; m < 4; ++m) _Pragma("unroll") for (int k = 0; k < 2; ++k) dst[m][k] = *(const PG8_LAS bf16x8*)(lds + PG8_SA(b, h) + aoff + m * 2048 + k * 1024); } while (0)
#define PG8_LDB(dst, b, h) do { _Pragma("unroll") for (int n = 0; n < 2; ++n) _Pragma("unroll") for (int k = 0; k < 2; ++k) dst[n][k] = *(const PG8_LAS bf16x8*)(lds + PG8_SB(b, h) + boff + n * 2048 + k * 1024); } while (0)
#define PG8_MMA(ai, bj, At, Bt) do { __builtin_amdgcn_s_setprio(1); _Pragma("unroll") for (int m = 0; m < 4; ++m) _Pragma("unroll") for (int n = 0; n < 2; ++n) _Pragma("unroll") for (int k = 0; k < 2; ++k) \
        acc[ai][bj][m][n] = __builtin_amdgcn_mfma_f32_16x16x32_bf16(Bt[n][k], At[m][k], acc[ai][bj][m][n], 0, 0, 0); __builtin_amdgcn_s_setprio(0); } while (0)
#define PG8_WAIT_V(n) asm volatile("s_waitcnt vmcnt(" #n ")" ::: "memory")
#define PG8_WAIT_L(n) asm volatile("s_waitcnt lgkmcnt(" #n ")" ::: "memory")
#define PG8_BAR __builtin_amdgcn_s_barrier()
#define PG8_SCHED __builtin_amdgcn_sched_barrier(0)
    Unit cur, nxt; int ui = 0;
    if (!S.next(0, cur)) return;
    f32x4 acc[2][2][4][2];
#pragma unroll
    for (int a = 0; a < 2; ++a)
#pragma unroll
        for (int b = 0; b < 2; ++b)
#pragma unroll
            for (int m = 0; m < 4; ++m)
#pragma unroll
                for (int n = 0; n < 2; ++n) acc[a][b][m][n] = (f32x4){0.f, 0.f, 0.f, 0.f};
    bf16x8 At[4][2], B0[2][2], B1[2][2];
    const char* cA = (const char*)g.A + (size_t)cur.pm * tstep; const char* cB = (const char*)g.Bt + (size_t)cur.pn * tstep;
    S.a_ready(cur);
    if constexpr (SP2) {
        PG8_STAGE(PG8_SB(0, 0), cB, voffB); PG8_STAGE(PG8_SB(0, 1), cB + hstep, voffB); PG8_STAGE(PG8_SA(0, 0), cA, voffA); PG8_STAGE(PG8_SA(0, 1), cA + hstep, voffA);
        if (wr == 1) PG8_BAR;
        PG8_WAIT_V(2); PG8_BAR;
        PG8_STAGE(PG8_SB(1, 0), cB + kstep, voffB); PG8_STAGE(PG8_SA(1, 0), cA + kstep, voffA); PG8_STAGE(PG8_SB(1, 1), cB + hstep + kstep, voffB);
        PG8_WAIT_V(6); PG8_BAR;
    } else {
        PG8_STAGE(PG8_SB(0, 0), cB, voffB); PG8_STAGE(PG8_SA(0, 0), cA, voffA); PG8_STAGE(PG8_SB(0, 1), cB + hstep, voffB); PG8_STAGE(PG8_SA(0, 1), cA + hstep, voffA);
        if (wr == 1) PG8_BAR;
        PG8_WAIT_V(4); PG8_BAR;
        PG8_STAGE(PG8_SB(1, 0), cB + kstep, voffB); PG8_STAGE(PG8_SA(1, 0), cA + kstep, voffA); PG8_STAGE(PG8_SB(1, 1), cB + hstep + kstep, voffB);
        PG8_WAIT_V(6); PG8_BAR;
    }
    for (;;) {
        const bool has_next = S.next(ui + 1, nxt);
        const char* nA = has_next ? (const char*)g.A + (size_t)nxt.pm * tstep : cA; const char* nB = has_next ? (const char*)g.Bt + (size_t)nxt.pn * tstep : cB;
        for (int t = 0; t < nt; t += 2) {
            const bool last = (t == nt - 2);
            const char* a1 = cA + (size_t)(t + 1) * kstep;
            const char* a2 = last ? nA : cA + (size_t)(t + 2) * kstep; const char* b2 = last ? nB : cB + (size_t)(t + 2) * kstep;
            const char* a3 = a2 + kstep; const char* b3 = b2 + kstep;
            if (last && has_next) S.a_ready(nxt);
            if constexpr (SP2) {
            PG8_LDB(B0, 0, 0); PG8_LDB(B1, 0, 1); PG8_SCHED; PG8_LDA(At, 0, 0); PG8_STAGE(PG8_SA(1, 1), a1 + hstep, voffA);
            PG8_WAIT_V(8); PG8_WAIT_L(0); PG8_BAR; PG8_MMA(0, 0, At, B0); PG8_MMA(0, 1, At, B1); PG8_BAR; PG8_SCHED;
            PG8_LDA(At, 0, 1); PG8_STAGE(PG8_SB(0, 0), b2, voffB); PG8_STAGE(PG8_SB(0, 1), b2 + hstep, voffB); PG8_STAGE(PG8_SA(0, 0), a2, voffA);
            PG8_WAIT_V(8); PG8_WAIT_L(0); PG8_BAR; PG8_MMA(1, 0, At, B0); PG8_MMA(1, 1, At, B1); PG8_BAR; PG8_SCHED;
            PG8_LDB(B0, 1, 0); PG8_LDB(B1, 1, 1); PG8_SCHED; PG8_LDA(At, 1, 0); PG8_STAGE(PG8_SA(0, 1), a2 + hstep, voffA);
            PG8_WAIT_V(8); PG8_WAIT_L(0); PG8_BAR; PG8_MMA(0, 0, At, B0); PG8_MMA(0, 1, At, B1); PG8_BAR; PG8_SCHED;
            PG8_LDA(At, 1, 1); PG8_STAGE(PG8_SB(1, 0), b3, voffB); PG8_STAGE(PG8_SB(1, 1), b3 + hstep, voffB); PG8_STAGE(PG8_SA(1, 0), a3, voffA);
            PG8_WAIT_V(8); PG8_WAIT_L(0); PG8_BAR; PG8_MMA(1, 0, At, B0); PG8_MMA(1, 1, At, B1); PG8_BAR; PG8_SCHED;
            } else {
            PG8_LDB(B0, 0, 0); PG8_SCHED; PG8_LDA(At, 0, 0); PG8_STAGE(PG8_SA(1, 1), a1 + hstep, voffA);
            PG8_WAIT_L(8); PG8_BAR; PG8_WAIT_L(0); PG8_MMA(0, 0, At, B0); PG8_BAR; PG8_SCHED;
            PG8_LDB(B1, 0, 1); PG8_STAGE(PG8_SB(0, 0), b2, voffB);
            PG8_BAR; PG8_WAIT_L(0); PG8_MMA(0, 1, At, B1); PG8_BAR;
            PG8_LDA(At, 0, 1); PG8_STAGE(PG8_SA(0, 0), a2, voffA);
            PG8_BAR; PG8_WAIT_L(0); PG8_MMA(1, 0, At, B0); PG8_BAR; PG8_SCHED;
            PG8_STAGE(PG8_SB(0, 1), b2 + hstep, voffB);
            PG8_WAIT_V(6); PG8_BAR; PG8_MMA(1, 1, At, B1); PG8_BAR;
            PG8_LDB(B0, 1, 0); PG8_SCHED; PG8_LDA(At, 1, 0); PG8_STAGE(PG8_SA(0, 1), a2 + hstep, voffA);
            PG8_WAIT_L(8); PG8_BAR; PG8_WAIT_L(0); PG8_MMA(0, 0, At, B0); PG8_BAR; PG8_SCHED;
            PG8_LDB(B1, 1, 1); PG8_STAGE(PG8_SB(1, 0), b3, voffB);
            PG8_BAR; PG8_WAIT_L(0); PG8_MMA(0, 1, At, B1); PG8_BAR;
            PG8_LDA(At, 1, 1); PG8_STAGE(PG8_SA(1, 0), a3, voffA);
            PG8_BAR; PG8_WAIT_L(0); PG8_MMA(1, 0, At, B0); PG8_BAR; PG8_SCHED;
            PG8_STAGE(PG8_SB(1, 1), b3 + hstep, voffB);
            PG8_WAIT_V(6); PG8_BAR; PG8_MMA(1, 1, At, B1); PG8_BAR;
            }
        }
        if constexpr (ALIGN_EPI) { if (wr == 0) PG8_BAR; }
        if constexpr (!Epi::AFTER_DRAIN) { E(acc, cur, wr, wc, fr, fq); S.done(cur); }
        if (!has_next) break;
#pragma unroll
        for (int a = 0; a < 2; ++a)
#pragma unroll
            for (int b = 0; b < 2; ++b)
#pragma unroll
                for (int m = 0; m < 4; ++m)
#pragma unroll
                    for (int n = 0; n < 2; ++n) acc[a][b][m][n] = (f32x4){0.f, 0.f, 0.f, 0.f};
        cur = nxt; cA = nA; cB = nB; ++ui;
        if constexpr (ALIGN_EPI) { if (wr == 1) PG8_BAR; }
    }
    PG8_WAIT_V(0);
    if constexpr (!ALIGN_EPI) { if (wr == 0) PG8_BAR; }
    PG8_BAR;
    if constexpr (Epi::AFTER_DRAIN) { E.fused(acc, cur, wr, wc, fr, fq, lds, wid, lane); S.done(cur); }
#undef PG8_SA
#undef PG8_SB
#undef PG8_STAGE
#undef PG8_LDA
#undef PG8_LDB
#undef PG8_MMA
#undef PG8_WAIT_V
#undef PG8_WAIT_L
#undef PG8_BAR
#undef PG8_SCHED
}
}
#define GAS __attribute__((address_space(1)))
#define LAS __attribute__((address_space(3)))
typedef unsigned short bf16;
typedef unsigned v4u __attribute__((ext_vector_type(4)));
typedef float f32x4 __attribute__((ext_vector_type(4)));
typedef short bf16x8 __attribute__((ext_vector_type(8)));
typedef GAS unsigned gu32;
typedef GAS unsigned long long gu64;
#define RLX_AGENT __ATOMIC_RELAXED, __HIP_MEMORY_SCOPE_AGENT
#define LDS_WAIT() asm volatile("s_waitcnt lgkmcnt(0)" ::: "memory")
#define VM_WAIT() asm volatile("s_waitcnt vmcnt(0)" ::: "memory")
__device__ __forceinline__ unsigned long long rt() { return __builtin_amdgcn_s_memrealtime(); }
__device__ __forceinline__ unsigned f2bf(float f) { unsigned u = __builtin_bit_cast(unsigned, f); return (u + 0x7fffu + ((u >> 16) & 1u)) >> 16; }
__device__ __forceinline__ unsigned pk2(float lo, float hi) { return f2bf(lo) | (f2bf(hi) << 16); }

#define XB_TMO      128
#define XB_XCNT(j)  (256  + 64 * (j))
#define XB_XSUB(j)  (1280 + 64 * (j))
#define XB_XGEN(j)  (2304 + 64 * (j))
#define XB_TOP      3328
#define XB_TOPGEN   3392
#define XCD_BAR_WORDS 3456
#define XB_SPIN_CAP (1u << 18)

__device__ __forceinline__ unsigned xb_ld(unsigned* p)              { return __hip_atomic_load(p, __ATOMIC_RELAXED, __HIP_MEMORY_SCOPE_AGENT); }
__device__ __forceinline__ unsigned xb_add(unsigned* p, unsigned v) { return __hip_atomic_fetch_add(p, v, __ATOMIC_RELAXED, __HIP_MEMORY_SCOPE_AGENT); }
__device__ __forceinline__ unsigned xb_xcc_id() { return (unsigned)__builtin_amdgcn_s_getreg((3 << 11) | 20) & 0xFu; }
#define XB_SPIN(cond, bar) do { unsigned _sp = 0; while (cond) { __builtin_amdgcn_s_sleep(1); \
    if ((++_sp & 255u) == 0u) { if (xb_ld(&(bar)[XB_TMO])) break; if (_sp > XB_SPIN_CAP) { atomicAdd(&(bar)[XB_TMO], 1u); break; } } } } while (0)

struct XcdBarrier {
    unsigned* bar; unsigned x;
    volatile LAS unsigned* st;
};

__device__ __forceinline__ XcdBarrier xcd_barrier_post(unsigned* bar, volatile LAS unsigned* st) {
    XcdBarrier b; b.bar = bar; b.x = xb_xcc_id(); b.st = st;
    if (threadIdx.x == 0) (void)xb_add(&bar[XB_XCNT(b.x)], 1u);
    return b;
}
__device__ __forceinline__ void xcd_barrier_complete(unsigned* bar, unsigned x, unsigned& nloc, unsigned& nx) {
    const unsigned G = gridDim.x * gridDim.y * gridDim.z;
    unsigned sum, cnt, mine, sp = 0u;
    for (;;) {
        sum = 0u; cnt = 0u; mine = 0u;
#pragma unroll
        for (unsigned j = 0; j < 16; ++j) { const unsigned c = xb_ld(&bar[XB_XCNT(j)]); sum += c; cnt += (c > 0u) ? 1u : 0u; mine = (j == x) ? c : mine; }
        if (sum == G) break;
        __builtin_amdgcn_s_sleep(1);
        if ((++sp & 255u) == 0u) { if (xb_ld(&bar[XB_TMO])) break; if (sp > XB_SPIN_CAP) { atomicAdd(&bar[XB_TMO], 1u); break; } }
    }
    nloc = mine > 0u ? mine : 1u; nx = cnt > 0u ? cnt : 1u;
}

__device__ __forceinline__ void xcd_barrier(const XcdBarrier& b) {
    asm volatile("s_waitcnt vmcnt(0)" ::: "memory");
    __syncthreads();
    if (threadIdx.x == 0) {
        unsigned* bar = b.bar;
        __builtin_amdgcn_s_waitcnt(0);
        unsigned nloc = b.st[0], nx = b.st[1];
        if (nloc == 0u) { xcd_barrier_complete(bar, b.x, nloc, nx); b.st[0] = nloc; b.st[1] = nx; }
        const unsigned old = xb_add(&bar[XB_XSUB(b.x)], 1u);
        const unsigned gen = old / nloc;
        if (old + 1u == (gen + 1u) * nloc) {
            __builtin_amdgcn_fence(__ATOMIC_RELEASE, "agent");
            asm volatile("s_waitcnt vmcnt(0)" ::: "memory");
            const unsigned og = xb_add(&bar[XB_TOP], 1u);
            const unsigned tg = og / nx;
            if (og + 1u == (tg + 1u) * nx) xb_add(&bar[XB_TOPGEN], 1u);
            else XB_SPIN(xb_ld(&bar[XB_TOPGEN]) == tg, bar);
            __builtin_amdgcn_fence(__ATOMIC_ACQUIRE, "agent");
            xb_add(&bar[XB_XGEN(b.x)], 1u);
            asm volatile("s_waitcnt vmcnt(0)" ::: "memory");
        } else {
            XB_SPIN(xb_ld(&bar[XB_XGEN(b.x)]) == gen, bar);
            __builtin_amdgcn_fence(__ATOMIC_ACQUIRE, "agent");
            asm volatile("s_waitcnt vmcnt(0)" ::: "memory");
        }
    }
    __syncthreads();
}
typedef float f32x2v __attribute__((ext_vector_type(2)));

constexpr int NWAVES = 8;
constexpr int BATCH = 8, SEQ = 2048, DM = 1024, MTOK = BATCH * SEQ, DFF = 4096, DIN = 6656, NMOD = 6 * DM;
constexpr float RMS_EPS = 1e-6f;
#ifndef MK_N_LAUNCHES
#define MK_N_LAUNCHES 10
#endif
constexpr int NPH = 10;
constexpr int N_LAUNCHES = MK_N_LAUNCHES;

constexpr size_t MiB = 1u << 20;
constexpr size_t WS_CTL = 0, CTL_ZERO_BYTES = 2 * MiB;
constexpr size_t WS_MOD = 1 * MiB;
constexpr size_t WS_X = 2 * MiB;
constexpr size_t WS_CS = 4 * MiB, WS_CST = 8 * MiB;
constexpr size_t WS_WNAT = 12 * MiB, WS_WTR = 22 * MiB, WS_WRET = 26 * MiB, WS_WSB = 28 * MiB, WS_WOUT = 29 * MiB, WS_WFF1 = 31 * MiB, WS_WFF2 = 39 * MiB;
constexpr size_t WS_H = 47 * MiB;
constexpr size_t WS_QR = 79 * MiB, WS_KR = 95 * MiB;
constexpr size_t WS_QS = 111 * MiB, WS_KS = 127 * MiB;
constexpr size_t WS_GR = 143 * MiB, WS_KRT = 175 * MiB, WS_VRT = 191 * MiB, WS_VST = 223 * MiB, WS_SB = 239 * MiB, WS_END = 255 * MiB;
constexpr size_t WS_MIX = 79 * MiB, WS_T = 111 * MiB, WS_Y = 111 * MiB  , WS_U = 79 * MiB  , WS_F = 207 * MiB  ;
constexpr int CW_TMO = 0, CW_CODE = 1, CW_BAR = 4096, CW_SEAM = 16384, SEAM_BANK = 128 * 64;

constexpr int RING_OFF = 0, RING_BYTES = 131072;
constexpr int LDSCTL_OFF = RING_BYTES, MISC_OFF = LDSCTL_OFF + 320;
constexpr int LDS_BYTES = 147456;

__device__ __forceinline__ float bf2f(bf16 v) { return __builtin_bit_cast(float, (unsigned)v << 16); }
__device__ __forceinline__ float wave_sum(float v) {
#pragma unroll
    for (int o = 1; o < 64; o <<= 1) v += __shfl_xor(v, o);
    return v;
}

struct Frame {
    LAS unsigned char* lds;
    volatile LAS unsigned* MISC;
    gu32* ctl;
    int tid, lane, wave, G;
    const float *x, *c, *ada_w, *ada_b, *pre_mix_g, *post_mix_g, *pre_ffn_g, *post_ffn_g, *w_in, *ret_gn_g, *w_ret, *w_sb, *w_out, *w_ff1, *w_ff2;
    const int* positions;
    float* out; unsigned char* ws;
};

struct MapNat { __device__ __forceinline__ int operator()(int r) const {
    if (r < 1024) { const int rr = r & 511, h = rr >> 6, rem = rr & 63; return (r & 512) + h * 64 + (rem >> 1) + 32 * (rem & 1); }
    if (r < 1536) return 3072 + (r - 1024);
    if (r < 2048) return 3584 + (r - 1536);
    if (r < 3072) return r;
    if (r < 4096) return 4608 + (r - 3072);
    return 5632 + (r - 4096); } };
struct MapTr { __device__ __forceinline__ int operator()(int r) const {
    if (r < 512) { const int h = r >> 6, rem = r & 63; return 512 + h * 64 + (rem >> 1) + 32 * (rem & 1); }
    if (r < 1536) return 1024 + (r - 512);
    return 4096 + (r - 1536); } };
struct MapId { __device__ __forceinline__ int operator()(int r) const { return r; } };

template <class Map> __device__ __forceinline__ void transpose_item(const float* W, int Nsrc, int K, bf16* WT, LAS float* scr, int item, int nblk, int lane, Map map) {
    const int kb = item / nblk, nb = item % nblk, k0 = 64 * kb, n0 = 32 * nb;
    const int sc = map(n0 + (lane & 31));
#pragma unroll 8
    for (int i = 0; i < 32; ++i) { const int kk = 2 * i + (lane >> 5); scr[kk * 33 + (lane & 31)] = W[(size_t)(k0 + kk) * Nsrc + sc]; }
    LDS_WAIT(); asm volatile("" ::: "memory");
    const int c = lane & 7;
#pragma unroll
    for (int j = 0; j < 4; ++j) { const int n = (lane >> 3) + 8 * j; const LAS float* s = scr + (8 * c) * 33 + n;
        v4u o; o.x = pk2(s[0 * 33], s[1 * 33]); o.y = pk2(s[2 * 33], s[3 * 33]); o.z = pk2(s[4 * 33], s[5 * 33]); o.w = pk2(s[6 * 33], s[7 * 33]);
        *(GAS v4u*)(WT + (size_t)(n0 + n) * K + k0 + 8 * c) = o; }
    LDS_WAIT(); asm volatile("" ::: "memory");
}

__device__ __forceinline__ void p0_mod(Frame& F) {
    LAS float* red = (LAS float*)(F.lds + RING_OFF);
    float* mod = (float*)(F.ws + WS_MOD);
    for (int item = blockIdx.x; item < 256; item += F.G) {
        const int cq = F.tid & 7, rl = F.tid >> 3;
        if (cq < 6) {
            f32x4 acc[8];
#pragma unroll
            for (int b = 0; b < 8; ++b) acc[b] = (f32x4){0.f, 0.f, 0.f, 0.f};
#pragma unroll 4
            for (int i = 0; i < 16; ++i) {
                const int k = rl + 64 * i;
                const f32x4 w = *(const f32x4*)(F.ada_w + (size_t)k * NMOD + item * 24 + cq * 4);
#pragma unroll
                for (int b = 0; b < 8; ++b) { const float cv = F.c[b * DM + k]; acc[b] += w * (cv * pg8::fsigmoid(cv)); }
            }
#pragma unroll
            for (int b = 0; b < 8; ++b) *(LAS f32x4*)(red + (rl * 8 + b) * 24 + cq * 4) = acc[b];
        }
        __syncthreads();
        if (F.tid < 192) { const int b = F.tid / 24, col = F.tid % 24; float s = 0.f;
            for (int r2 = 0; r2 < 64; ++r2) s += red[(r2 * 8 + b) * 24 + col];
            mod[b * NMOD + item * 24 + col] = s + F.ada_b[item * 24 + col]; }
        __syncthreads();
    }
}

__device__ __forceinline__ void rot_cs(int pos, int i, float& c, float& s) {
    const float invf = (float)exp2(-(double)i * (13.287712379549449 / 32.0));
    const float ang = (float)pos * invf;
    const double turns = (double)ang * 0.15915494309189535;
    const float fr = (float)(turns - rint(turns));
    c = __builtin_amdgcn_cosf(fr); s = __builtin_amdgcn_sinf(fr);
}

__device__ __forceinline__ void p0_prologue(Frame& F) {
    p0_mod(F);
    __syncthreads();
    LAS float* scr = (LAS float*)(F.lds + RING_OFF + F.wave * 16384);
    const int gw = blockIdx.x * NWAVES + F.wave, NGW = F.G * NWAVES;
    bf16* Wnat = (bf16*)(F.ws + WS_WNAT); bf16* Wtr = (bf16*)(F.ws + WS_WTR); bf16* Wret = (bf16*)(F.ws + WS_WRET); bf16* Wsb = (bf16*)(F.ws + WS_WSB);
    bf16* Wout = (bf16*)(F.ws + WS_WOUT); bf16* Wff1 = (bf16*)(F.ws + WS_WFF1); bf16* Wff2 = (bf16*)(F.ws + WS_WFF2);
    constexpr int I_NAT = 16 * 160, I_TR = 16 * 64, I_RET = 16 * 32, I_SB = 8 * 32, I_OUT = 16 * 32, I_FF1 = 16 * 128, I_FF2 = 64 * 32;
    constexpr int NITEMS = I_NAT + I_TR + I_RET + I_SB + I_OUT + I_FF1 + I_FF2;
    for (int it = gw; it < NITEMS; it += NGW) {
        int r = it;
        if (r < I_NAT) { transpose_item(F.w_in, DIN, DM, Wnat, scr, r, 160, F.lane, MapNat()); continue; } r -= I_NAT;
        if (r < I_TR)  { transpose_item(F.w_in, DIN, DM, Wtr, scr, r, 64, F.lane, MapTr()); continue; } r -= I_TR;
        if (r < I_RET) { transpose_item(F.w_ret, DM, DM, Wret, scr, r, 32, F.lane, MapId()); continue; } r -= I_RET;
        if (r < I_SB)  { transpose_item(F.w_sb, DM, 512, Wsb, scr, r, 32, F.lane, MapId()); continue; } r -= I_SB;
        if (r < I_OUT) { transpose_item(F.w_out, DM, DM, Wout, scr, r, 32, F.lane, MapId()); continue; } r -= I_OUT;
        if (r < I_FF1) { transpose_item(F.w_ff1, DFF, DM, Wff1, scr, r, 128, F.lane, MapId()); continue; } r -= I_FF1;
        transpose_item(F.w_ff2, DM, DFF, Wff2, scr, r, 32, F.lane, MapId());
    }
    float* cs = (float*)(F.ws + WS_CS); float* csT = (float*)(F.ws + WS_CST);
    const int gt = blockIdx.x * (NWAVES * 64) + F.tid, NGT = F.G * NWAVES * 64;
    for (int idx = gt; idx < MTOK * 32; idx += NGT) { const int tok = idx >> 5, i = idx & 31; float c, s; rot_cs(F.positions[tok], i, c, s); *(f32x2v*)(cs + (size_t)idx * 2) = (f32x2v){c, s}; }
    for (int idx = gt; idx < MTOK * 32; idx += NGT) { const int i = idx >> 14, tok = idx & (MTOK - 1); float c, s; rot_cs(F.positions[tok], i, c, s); *(f32x2v*)(csT + (size_t)idx * 2) = (f32x2v){c, s}; }
}

__device__ __forceinline__ unsigned long long pk4(float a, float b, float c, float d) { return (unsigned long long)pk2(a, b) | ((unsigned long long)pk2(c, d) << 32); }
__device__ __forceinline__ void p1_rows(Frame& F) {
    const int gw = blockIdx.x * NWAVES + F.wave, NGW = F.G * NWAVES;
    const float* mod = (const float*)(F.ws + WS_MOD); bf16* H = (bf16*)(F.ws + WS_H);
    for (int m = gw; m < MTOK; m += NGW) {
        const int b = m >> 11;
        const GAS f32x4* xr = (const GAS f32x4*)(F.x + (size_t)m * DM) + F.lane;
        f32x4 v[4]; float ss = 0.f;
#pragma unroll
        for (int j = 0; j < 4; ++j) { v[j] = xr[64 * j]; ss += (v[j].x * v[j].x + v[j].y * v[j].y) + (v[j].z * v[j].z + v[j].w * v[j].w); }
        const float rstd = 1.0f / sqrtf(wave_sum(ss) * (1.0f / DM) + RMS_EPS);
        GAS unsigned long long* o8 = (GAS unsigned long long*)(H + (size_t)m * DM) + F.lane;
#pragma unroll
        for (int j = 0; j < 4; ++j) {
            const int col = 4 * F.lane + 256 * j;
            const f32x4 g = *(const f32x4*)(F.pre_mix_g + col), sh = *(const f32x4*)(mod + b * NMOD + col), sc = *(const f32x4*)(mod + b * NMOD + DM + col);
            const f32x4 o = (v[j] * rstd) * g * (sc + 1.0f) + sh;
            o8[64 * j] = pk4(o.x, o.y, o.z, o.w);
        }
    }
}

__device__ __forceinline__ void p6_rows(Frame& F) {
    const int gw = blockIdx.x * NWAVES + F.wave, NGW = F.G * NWAVES;
    const float* mod = (const float*)(F.ws + WS_MOD); const float* Y = (const float*)(F.ws + WS_Y); bf16* H2 = (bf16*)(F.ws + WS_H);
    for (int m = gw; m < MTOK; m += NGW) {
        const int b = m >> 11;
        const GAS f32x4* yr = (const GAS f32x4*)(Y + (size_t)m * DM) + F.lane;
        const GAS f32x4* xr = (const GAS f32x4*)(F.x + (size_t)m * DM) + F.lane;
        f32x4 v[4]; float ss = 0.f;
#pragma unroll
        for (int j = 0; j < 4; ++j) { v[j] = yr[64 * j]; ss += (v[j].x * v[j].x + v[j].y * v[j].y) + (v[j].z * v[j].z + v[j].w * v[j].w); }
        const float rstd1 = 1.0f / sqrtf(wave_sum(ss) * (1.0f / DM) + RMS_EPS);
        float s2 = 0.f;
        GAS f32x4* orow = (GAS f32x4*)(F.out + (size_t)m * DM) + F.lane;
#pragma unroll
        for (int j = 0; j < 4; ++j) {
            const int col = 4 * F.lane + 256 * j;
            const f32x4 g = *(const f32x4*)(F.post_mix_g + col), gt = *(const f32x4*)(mod + b * NMOD + 2 * DM + col);
            v[j] = xr[64 * j] + gt * ((v[j] * rstd1) * g);
            orow[64 * j] = v[j];
            s2 += (v[j].x * v[j].x + v[j].y * v[j].y) + (v[j].z * v[j].z + v[j].w * v[j].w);
        }
        const float rstd2 = 1.0f / sqrtf(wave_sum(s2) * (1.0f / DM) + RMS_EPS);
        GAS unsigned long long* o8 = (GAS unsigned long long*)(H2 + (size_t)m * DM) + F.lane;
#pragma unroll
        for (int j = 0; j < 4; ++j) {
            const int col = 4 * F.lane + 256 * j;
            const f32x4 g = *(const f32x4*)(F.pre_ffn_g + col), sh = *(const f32x4*)(mod + b * NMOD + 3 * DM + col), sc = *(const f32x4*)(mod + b * NMOD + 4 * DM + col);
            const f32x4 o = (v[j] * rstd2) * g * (sc + 1.0f) + sh;
            o8[64 * j] = pk4(o.x, o.y, o.z, o.w);
        }
    }
}
__device__ __forceinline__ void p9_rows(Frame& F) {
    const int gw = blockIdx.x * NWAVES + F.wave, NGW = F.G * NWAVES;
    const float* mod = (const float*)(F.ws + WS_MOD); const bf16* Fb = (const bf16*)(F.ws + WS_F);
    for (int m = gw; m < MTOK; m += NGW) {
        const int b = m >> 11;
        const GAS unsigned long long* fr = (const GAS unsigned long long*)(Fb + (size_t)m * DM) + F.lane;
        f32x4 v[4]; float ss = 0.f;
#pragma unroll
        for (int j = 0; j < 4; ++j) { const unsigned long long w = fr[64 * j]; const unsigned lo = (unsigned)w, hi = (unsigned)(w >> 32);
            v[j] = (f32x4){pg8::bflo(lo), pg8::bfhi(lo), pg8::bflo(hi), pg8::bfhi(hi)};
            ss += (v[j].x * v[j].x + v[j].y * v[j].y) + (v[j].z * v[j].z + v[j].w * v[j].w); }
        const float rstd = 1.0f / sqrtf(wave_sum(ss) * (1.0f / DM) + RMS_EPS);
        GAS f32x4* orow = (GAS f32x4*)(F.out + (size_t)m * DM) + F.lane;
#pragma unroll
        for (int j = 0; j < 4; ++j) {
            const int col = 4 * F.lane + 256 * j;
            const f32x4 g = *(const f32x4*)(F.post_ffn_g + col), gt = *(const f32x4*)(mod + b * NMOD + 5 * DM + col);
            orow[64 * j] = orow[64 * j] + gt * ((v[j] * rstd) * g);
        }
    }
}

__device__ __forceinline__ void naive_retention(Frame& F, int bh) {
    const int b = bh >> 3, h = bh & 7, tid = F.tid, lane = F.lane, wave = F.wave;
    const float lg = pg8::log2gamma(h);
    LAS float* S = (LAS float*)(F.lds);
    LAS float* qL = S + 64 * 128;
    LAS float* kL = qL + 64 * 65;
    LAS float* sL = kL + 64 * 65;
    LAS float* vL = sL + 64 * 65;
    LAS float* st = vL + 64 * 128;
    const bf16* QR = (const bf16*)(F.ws + WS_QR); const bf16* KR = (const bf16*)(F.ws + WS_KR); const bf16* KRT = (const bf16*)(F.ws + WS_KRT);
    const bf16* VRT = (const bf16*)(F.ws + WS_VRT); const bf16* GR = (const bf16*)(F.ws + WS_GR); bf16* RG = (bf16*)(F.ws + WS_H);
    for (int i = tid; i < 64 * 128; i += 512) S[i] = 0.f;
    const float g64 = __builtin_amdgcn_exp2f(lg * 64.0f);
    for (int n = 0; n < 32; ++n) {
        const int tok0 = b * SEQ + n * 64;
        __syncthreads();
        for (int r = 0; r < 8; ++r) { const int idx = tid + 512 * r, i = idx >> 6, d = idx & 63;
            qL[i * 65 + d] = bf2f(QR[(size_t)(tok0 + i) * 512 + h * 64 + d]); kL[i * 65 + d] = bf2f(KR[(size_t)(tok0 + i) * 512 + h * 64 + d]); }
        for (int r = 0; r < 16; ++r) { const int idx = tid + 512 * r, e = idx >> 6, j = idx & 63; vL[j * 128 + e] = bf2f(VRT[(size_t)(h * 128 + e) * MTOK + tok0 + j]); }
        __syncthreads();
        for (int r = 0; r < 8; ++r) { const int idx = tid + 512 * r, i = idx >> 6, j = idx & 63; float s = 0.f;
            for (int d = 0; d < 64; ++d) s += qL[i * 65 + d] * kL[j * 65 + d];
            const int dist = i > j ? i - j : j - i;
            sL[i * 65 + j] = s * __builtin_amdgcn_exp2f(lg * (float)dist); }
        __syncthreads();
        const int e = tid & 127, ig = tid >> 7;
        float rv[16];
#pragma unroll
        for (int kq = 0; kq < 16; ++kq) { const int i = ig + 4 * kq; float intra = 0.f, cross = 0.f;
            for (int j = 0; j < 64; ++j) intra += sL[i * 65 + j] * vL[j * 128 + e];
            for (int d = 0; d < 64; ++d) cross += qL[i * 65 + d] * S[d * 128 + e];
            rv[kq] = intra + __builtin_amdgcn_exp2f(lg * (float)(i + 1)) * cross; }
#pragma unroll
        for (int kq = 0; kq < 16; ++kq) { const float s1 = wave_sum(rv[kq]); if (lane == 0) st[(ig + 4 * kq) * 4 + (wave & 1)] = s1; }
        __syncthreads();
#pragma unroll
        for (int kq = 0; kq < 16; ++kq) { const int i = ig + 4 * kq; const float mu = (st[i * 4] + st[i * 4 + 1]) * (1.0f / 128.0f); rv[kq] -= mu;
            const float s2 = wave_sum(rv[kq] * rv[kq]); if (lane == 0) st[i * 4 + 2 + (wave & 1)] = s2; }
        __syncthreads();
#pragma unroll
        for (int kq = 0; kq < 16; ++kq) { const int i = ig + 4 * kq; const float var = (st[i * 4 + 2] + st[i * 4 + 3]) * (1.0f / 128.0f);
            const float o = rv[kq] * (1.0f / sqrtf(var + RMS_EPS)) * F.ret_gn_g[h * 128 + e] * bf2f(GR[(size_t)(tok0 + i) * DM + h * 128 + e]);
            RG[(size_t)(tok0 + i) * DM + h * 128 + e] = (bf16)f2bf(o); }
#pragma unroll 4
        for (int kq = 0; kq < 16; ++kq) { const int d = ig + 4 * kq; float a = 0.f;
            const bf16* kp = KRT + (size_t)(h * 64 + d) * MTOK + tok0;
            for (int j = 0; j < 64; ++j) a += bf2f(kp[j]) * vL[j * 128 + e];
            S[d * 128 + e] = S[d * 128 + e] * g64 + a; }
    }
    __syncthreads();
}

__device__ __forceinline__ void naive_sb_row(Frame& F, int ri) {
    const int lane = F.lane;
    const int t = ri & (SEQ - 1), bh = ri >> 11, b = bh >> 3, h = bh & 7;
    const bf16* QS = (const bf16*)(F.ws + WS_QS); const bf16* KS = (const bf16*)(F.ws + WS_KS); const bf16* VST = (const bf16*)(F.ws + WS_VST); bf16* SB = (bf16*)(F.ws + WS_SB);
    LAS float* qL = (LAS float*)(F.lds) + F.wave * 64;
    qL[lane] = bf2f(QS[(size_t)(b * SEQ + t) * 512 + h * 64 + lane]);
    LDS_WAIT(); asm volatile("" ::: "memory");
    float acc[64];
#pragma unroll
    for (int d = 0; d < 64; ++d) acc[d] = 0.f;
    float R = 0.f;
    for (int sb = (t - 1) >> 6; sb >= 0; --sb) {
        const int s = sb * 64 + lane; const bool valid = s < t;
        const v4u* kp = (const v4u*)(KS + (size_t)(b * SEQ + s) * 512 + h * 64);
        float z = 0.f;
#pragma unroll
        for (int c8 = 0; c8 < 8; ++c8) { const v4u w = kp[c8];
            z += qL[c8 * 8 + 0] * pg8::bflo(w.x) + qL[c8 * 8 + 1] * pg8::bfhi(w.x) + qL[c8 * 8 + 2] * pg8::bflo(w.y) + qL[c8 * 8 + 3] * pg8::bfhi(w.y)
               + qL[c8 * 8 + 4] * pg8::bflo(w.z) + qL[c8 * 8 + 5] * pg8::bfhi(w.z) + qL[c8 * 8 + 6] * pg8::bflo(w.w) + qL[c8 * 8 + 7] * pg8::bfhi(w.w); }
        const float ez = __builtin_amdgcn_exp2f(-__builtin_fabsf(z)), l = __builtin_amdgcn_logf(1.0f + ez);
        const float sp = valid ? __builtin_fmaxf(z, 0.f) + l : 0.f;
        float incl = sp;
#pragma unroll
        for (int off = 1; off < 64; off <<= 1) { const float v = __shfl_down(incl, off); if (lane + off < 64) incl += v; }
        const float total = __shfl(incl, 0);
        const float a = valid ? __builtin_amdgcn_exp2f(__builtin_fminf(z, 0.f) - l - ((incl - sp) + R)) : 0.f;
        R += total;
        const bf16* vp = VST + (size_t)(h * 64) * MTOK + b * SEQ + s;
#pragma unroll
        for (int d = 0; d < 64; ++d) acc[d] += a * bf2f(vp[(size_t)d * MTOK]);
    }
    float outv = 0.f;
#pragma unroll
    for (int d = 0; d < 64; ++d) { const float s = wave_sum(acc[d]); if (lane == d) outv = s; }
    SB[(size_t)(b * SEQ + t) * 512 + h * 64 + lane] = (bf16)f2bf(outv);
    LDS_WAIT(); asm volatile("" ::: "memory");
}

__device__ __forceinline__ void p3_mixers_naive(Frame& F) {
#ifdef KO_MIXERS
    { const bf16* GR = (const bf16*)(F.ws + WS_GR); const bf16* QS = (const bf16*)(F.ws + WS_QS); bf16* RG = (bf16*)(F.ws + WS_H); bf16* SB = (bf16*)(F.ws + WS_SB);
      const size_t gt = (size_t)blockIdx.x * 512 + F.tid, NGT = (size_t)F.G * 512;
      for (size_t i = gt; i < (size_t)MTOK * DM; i += NGT) RG[i] = GR[i];
      for (size_t i = gt; i < (size_t)MTOK * 512; i += NGT) SB[i] = QS[i];
      return; }
#endif
    for (int bh = blockIdx.x; bh < 64; bh += F.G) naive_retention(F, bh);
    __syncthreads();
    const int gw = blockIdx.x * NWAVES + F.wave, NGW = F.G * NWAVES;
    for (int ri = gw; ri < 64 * SEQ; ri += NGW) naive_sb_row(F, ri);
    __syncthreads();
}

struct Args { const void* in[16]; float* out; unsigned char* ws; int ph_lo, ph_hi, li, pad; };
__global__ void __launch_bounds__(NWAVES * 64, 2) skel_fwd(Args args) {
    extern __shared__ __attribute__((aligned(16))) unsigned char lds[];
    Frame F;
    F.lds = (LAS unsigned char*)lds;
    F.MISC = (volatile LAS unsigned*)(F.lds + MISC_OFF);
    F.tid = threadIdx.x; F.lane = F.tid & 63; F.wave = __builtin_amdgcn_readfirstlane(F.tid >> 6);
    F.G = gridDim.x;
    F.ws = args.ws; F.out = args.out; F.ctl = (gu32*)(args.ws + WS_CTL);
    F.x = (const float*)args.in[0]; F.c = (const float*)args.in[1]; F.positions = (const int*)args.in[2]; F.ada_w = (const float*)args.in[3]; F.ada_b = (const float*)args.in[4];
    F.pre_mix_g = (const float*)args.in[5]; F.post_mix_g = (const float*)args.in[6]; F.pre_ffn_g = (const float*)args.in[7]; F.post_ffn_g = (const float*)args.in[8];
    F.w_in = (const float*)args.in[9]; F.ret_gn_g = (const float*)args.in[10]; F.w_ret = (const float*)args.in[11]; F.w_sb = (const float*)args.in[12]; F.w_out = (const float*)args.in[13];
    F.w_ff1 = (const float*)args.in[14]; F.w_ff2 = (const float*)args.in[15];
    unsigned char* ws = args.ws;
    for (int u = F.tid; u < (LDS_BYTES - LDSCTL_OFF) / 4; u += NWAVES * 64) ((LAS unsigned*)(F.lds + LDSCTL_OFF))[u] = 0u;
    __syncthreads();
    XcdBarrier bar; bar.bar = (unsigned*)(F.ctl + CW_BAR); bar.x = 0; bar.st = nullptr;
    if (N_LAUNCHES != NPH) bar = xcd_barrier_post((unsigned*)(F.ctl + CW_BAR), F.MISC + 8);
#define GRID_BAR() do { if (N_LAUNCHES != NPH) xcd_barrier(bar); } while (0)
    const int lo = args.ph_lo, hi = args.ph_hi;
#define IN(k) (lo <= (k) && (k) < hi)
#define BOTH(k) (IN(k) && IN((k) + 1))
    bf16* H = (bf16*)(ws + WS_H);
    if (IN(0)) { p0_prologue(F); if (BOTH(0)) GRID_BAR(); }
    if (IN(1)) { p1_rows(F); if (BOTH(1)) GRID_BAR(); }
    if (IN(2)) {
        {   pg8::Gemm g{H, (const bf16*)(ws + WS_WNAT), MTOK, 5120, DM}; pg8::StaticOrder S; S.init(MTOK, 5120, F.G, (int)blockIdx.x);
            pg8::EpiProjNat E{(bf16*)(ws + WS_QR), (bf16*)(ws + WS_KR), (bf16*)(ws + WS_QS), (bf16*)(ws + WS_KS), (bf16*)(ws + WS_GR), (bf16*)F.out, (bf16*)F.out + (size_t)MTOK * DM, (const float*)(ws + WS_CS)};
            pg8::gemm_phase<pg8::EpiProjNat, pg8::StaticOrder, true, true>(F.lds + RING_OFF, g, S, E); }
        {   pg8::Gemm g{(const bf16*)(ws + WS_WTR), H, 2048, MTOK, DM}; pg8::StaticOrder S; S.init(2048, MTOK, F.G, (int)blockIdx.x);
            pg8::EpiProjTr E{(bf16*)(ws + WS_KRT), (bf16*)(ws + WS_VRT), (bf16*)(ws + WS_VST), (const float*)(ws + WS_CST)};
            pg8::gemm_phase<pg8::EpiProjTr, pg8::StaticOrder, true, true>(F.lds + RING_OFF, g, S, E); }
        if (BOTH(2)) GRID_BAR();
    }
    if (IN(3)) { p3_mixers_naive(F); if (BOTH(3)) GRID_BAR(); }
    if (IN(4)) {
        {   pg8::Gemm g{H  , (const bf16*)(ws + WS_WRET), MTOK, DM, DM}; pg8::StaticOrder S; S.init(MTOK, DM, F.G, (int)blockIdx.x);
            pg8::EpiMerge<false> E{(const bf16*)F.out, nullptr, (bf16*)(ws + WS_T)};
            pg8::gemm_phase<pg8::EpiMerge<false>, pg8::StaticOrder, true, true>(F.lds + RING_OFF, g, S, E); }
        asm volatile("s_waitcnt vmcnt(0)" ::: "memory"); __syncthreads();
        {   pg8::Gemm g{(const bf16*)(ws + WS_SB), (const bf16*)(ws + WS_WSB), MTOK, DM, 512}; pg8::StaticOrder S; S.init(MTOK, DM, F.G, (int)blockIdx.x);
            pg8::EpiMerge<true> E{(const bf16*)F.out + (size_t)MTOK * DM, (const bf16*)(ws + WS_T), (bf16*)(ws + WS_MIX)};
            pg8::gemm_phase<pg8::EpiMerge<true>, pg8::StaticOrder, true, true>(F.lds + RING_OFF, g, S, E); }
        if (BOTH(4)) GRID_BAR();
    }
    if (IN(5)) {
        pg8::Gemm g{(const bf16*)(ws + WS_MIX), (const bf16*)(ws + WS_WOUT), MTOK, DM, DM}; pg8::StaticOrder S; S.init(MTOK, DM, F.G, (int)blockIdx.x);
        pg8::EpiF32 E{(float*)(ws + WS_Y), DM};
        pg8::gemm_phase<pg8::EpiF32, pg8::StaticOrder, true, true>(F.lds + RING_OFF, g, S, E);
        if (BOTH(5)) GRID_BAR();
    }
    if (IN(6)) { p6_rows(F); if (BOTH(6)) GRID_BAR(); }
    if (IN(7)) {
        pg8::Gemm g{H  , (const bf16*)(ws + WS_WFF1), MTOK, DFF, DM}; pg8::StaticOrder S; S.init(MTOK, DFF, F.G, (int)blockIdx.x);
        pg8::EpiBf<1> E{(bf16*)(ws + WS_U), DFF};
        pg8::gemm_phase<pg8::EpiBf<1>, pg8::StaticOrder, true, true>(F.lds + RING_OFF, g, S, E);
        if (BOTH(7)) GRID_BAR();
    }
    if (IN(8)) {
        pg8::Gemm g{(const bf16*)(ws + WS_U), (const bf16*)(ws + WS_WFF2), MTOK, DM, DFF}; pg8::StaticOrder S; S.init(MTOK, DM, F.G, (int)blockIdx.x);
        pg8::EpiBf<0> E{(bf16*)(ws + WS_F), DM};
        pg8::gemm_phase<pg8::EpiBf<0>, pg8::StaticOrder, true, true>(F.lds + RING_OFF, g, S, E);
        if (BOTH(8)) GRID_BAR();
    }
    if (IN(9)) { p9_rows(F); }
#ifdef PROBE_STOP
    {   const size_t gt = (size_t)blockIdx.x * 512 + F.tid, NGT = (size_t)F.G * 512;
        float* dig = (float*)(ws + WS_SB);
        const size_t N4 = (size_t)4 << 20;
        if (IN(10)) {
            const bf16* a = (const bf16*)F.out;
            for (size_t j = gt; j < N4; j += NGT) { float v = 0.f; for (int q = 0; q < 8; ++q) v += bf2f(a[j + q * N4]); dig[j] = v; }
        }
        if (IN(11)) {
            const bf16* Hh = (const bf16*)(ws + WS_H); const bf16* Wall = (const bf16*)(ws + WS_WNAT); const float* cs = (const float*)(ws + WS_CS); const float* mod = (const float*)(ws + WS_MOD);
            const bf16* act = (const bf16*)(ws + WS_QR);
            const size_t NW = (size_t)35 << 19;
            for (size_t i = gt; i < (size_t)MTOK * DM; i += NGT) {
                float v = bf2f(Hh[i]) + bf2f(Wall[i % NW]) + bf2f(Wall[(i + ((size_t)16 << 20)) % NW]) + cs[i % ((size_t)2 << 20)] + mod[i % 49152];
#if PROBE_STOP >= 2
                for (int q = 0; q < 5; ++q) v += bf2f(act[i + q * ((size_t)16 << 20)]);
                v += dig[i % N4];
#endif
                F.out[i] = v;
            }
        }
    }
#endif
#undef IN
#undef BOTH
}

extern "C" void kernel_launch(void* const* d_in, const int* in_sizes, int n_in, void* d_out, int out_size, void* d_ws, size_t ws_size, hipStream_t stream) {
    static int grid = 0;
    if (grid == 0) {
        if (n_in != 16 || out_size != MTOK * DM || ws_size < WS_END) { fprintf(stderr, "kernel_launch: unexpected shapes (n_in %d out %d ws %zu)\n", n_in, out_size, ws_size); grid = -1; return; }
        int dev = 0, cus = 0;
        if (hipGetDevice(&dev) != hipSuccess || hipDeviceGetAttribute(&cus, hipDeviceAttributeMultiprocessorCount, dev) != hipSuccess) { grid = -1; return; }
        if (hipFuncSetAttribute((const void*)skel_fwd, hipFuncAttributeMaxDynamicSharedMemorySize, LDS_BYTES) != hipSuccess) { fprintf(stderr, "kernel_launch: hipFuncSetAttribute failed\n"); grid = -1; return; }
        (void)hipGetLastError();
        grid = cus;
    }
    if (grid < 0) return;
    if (hipMemsetAsync((char*)d_ws + WS_CTL, 0, CTL_ZERO_BYTES, stream) != hipSuccess) return;
    Args a{};
    for (int i = 0; i < 16; ++i) a.in[i] = d_in[i];
    a.out = (float*)d_out; a.ws = (unsigned char*)d_ws;
#ifdef PROBE_STOP
    for (int li = 0; li < 12; ++li) {
        if (li > PROBE_STOP && li < 10) continue;
        if (li == 10 && PROBE_STOP < 2) continue;
        a.ph_lo = li; a.ph_hi = li + 1; a.li = li;
        hipLaunchKernelGGL(skel_fwd, dim3(grid), dim3(NWAVES * 64), LDS_BYTES, stream, a);
    }
#else
    for (int li = 0; li < N_LAUNCHES; ++li) {
        if (N_LAUNCHES == NPH) { a.ph_lo = li; a.ph_hi = li + 1; } else { a.ph_lo = 0; a.ph_hi = NPH; }
        a.li = li;
        hipLaunchKernelGGL(skel_fwd, dim3(grid), dim3(NWAVES * 64), LDS_BYTES, stream, a);
    }
#endif
}
```

```cpp
#include <hip/hip_runtime.h>
#include <cstdio>
#include <cstdint>
#include <cmath>
#define MK_N_LAUNCHES 1
namespace pg8 {
#define PG8_LAS __attribute__((address_space(3)))
typedef unsigned short bf16_t;
typedef short bf16x8 __attribute__((ext_vector_type(8)));
typedef float f32x4 __attribute__((ext_vector_type(4)));
typedef unsigned u32x4 __attribute__((ext_vector_type(4)));
constexpr int BM = 256, BK = 64, HALF = 128, HTB = HALF * BK * 2  , STAGE_BYTES = 8 * HTB, NXCD = 8, WGM = 8;

__host__ __device__ __forceinline__ int lds_byte(int r, int c) { const int st = (r >> 4) * 2 + (c >> 5), rr = r & 15, cc = c & 31, ob = rr * 64 + cc * 2; return st * 1024 + (ob ^ (((ob >> 9) & 1) << 5)); }
__host__ __device__ __forceinline__ void stage_rc(int b, int& R, int& C) { const int st = b / 1024, sb = b % 1024, swz = sb ^ (((sb >> 9) & 1) << 5); R = (st >> 1) * 16 + swz / 64; C = (st & 1) * 32 + (swz % 64) / 2; }
__host__ __device__ __forceinline__ int perm32(int rho) { const int n = rho >> 4, i = rho & 15; return 8 * (i >> 2) + 4 * n + (i & 3); }

struct Unit { int pm, pn; };
struct Gemm { const bf16_t* A; const bf16_t* Bt; int M, N, K; };

struct StaticOrder {
    int nM, nN, nwg, G, c;
    __host__ __device__ void init(int M, int N, int G_, int c_) { nM = M / BM; nN = N / BM; nwg = nM * nN; G = G_; c = c_; }
    __host__ __device__ bool next(int i, Unit& u) const {
        const long L = (long)i * G + c; if (L >= nwg) return false;
        int wgid = (int)L; { const int q = nwg / NXCD, r = nwg % NXCD, xcd = wgid % NXCD, off = wgid / NXCD; wgid = (xcd < r ? xcd * (q + 1) : r * (q + 1) + (xcd - r) * q) + off; }
        const int nig = WGM * nN, gid = wgid / nig, fm = gid * WGM, gsz = (nM - fm) < WGM ? (nM - fm) : WGM;
        u.pm = fm + ((wgid % nig) % gsz); u.pn = (wgid % nig) / gsz; return true;
    }
    __device__ __forceinline__ void a_ready(const Unit&) const {}
    __device__ __forceinline__ void done(const Unit&) const {}
};

__device__ __forceinline__ unsigned cvt_pk_bf16(float lo, float hi) { unsigned r; asm volatile("s_nop 0\n\tv_cvt_pk_bf16_f32 %0, %1, %2" : "=v"(r) : "v"(lo), "v"(hi)); return r; }
typedef float f32x2 __attribute__((ext_vector_type(2)));
constexpr int MTOKc = 16384;
constexpr float QS_SCALE = 0.125f * 1.4426950408889634f;
__device__ __forceinline__ float fsigmoid(float x) { return __builtin_amdgcn_rcpf(1.0f + __builtin_amdgcn_exp2f(-1.4426950408889634f * x)); }
__device__ __forceinline__ float bflo(unsigned w) { return __builtin_bit_cast(float, w << 16); }
__device__ __forceinline__ float bfhi(unsigned w) { return __builtin_bit_cast(float, w & 0xffff0000u); }
__device__ __forceinline__ void st8(bf16_t* p, const f32x4& a, const f32x4& b) {
    u32x4 w; w.x = cvt_pk_bf16(a[0], a[1]); w.y = cvt_pk_bf16(a[2], a[3]); w.z = cvt_pk_bf16(b[0], b[1]); w.w = cvt_pk_bf16(b[2], b[3]);
    *(u32x4*)p = w;
}
__device__ __forceinline__ float log2gamma(int h) { return __builtin_amdgcn_logf(1.0f - __builtin_amdgcn_exp2f((float)(-5 - h))); }

struct EpiProjNat {
    static constexpr bool PERM = true, AFTER_DRAIN = false;
    bf16_t *QR, *KR, *QS, *KS, *GR, *AR, *AS; const float* cs;
    template <int MODE> __device__ __forceinline__ void body(const f32x4 (&acc)[2][2][4][2], bf16_t* base, int ldc, int row0, int col0) const {
#pragma unroll
        for (int ai = 0; ai < 2; ++ai)
#pragma unroll
            for (int m = 0; m < 4; ++m) {
                const int row = row0 + ai * HALF + m * 16;
                bf16_t* rowp = base + (size_t)row * ldc + col0;
#pragma unroll
                for (int bj = 0; bj < 2; ++bj) {
                    f32x4 v0 = acc[ai][bj][m][0], v1 = acc[ai][bj][m][1];
                    if (MODE == 0 || MODE == 1) {
                        const int i0 = (col0 & 63) >> 1;
                        const f32x4 c01 = *(const f32x4*)(cs + ((size_t)row * 32 + i0) * 2);
                        const f32x4 c23 = *(const f32x4*)(cs + ((size_t)row * 32 + i0 + 2) * 2);
                        const float sc = (MODE == 1) ? 0.125f : 1.0f;
                        f32x4 o0, o1;
                        o0[0] = (v0[0] * c01[0] - v0[1] * c01[1]) * sc; o0[1] = (v0[0] * c01[1] + v0[1] * c01[0]) * sc;
                        o0[2] = (v0[2] * c01[2] - v0[3] * c01[3]) * sc; o0[3] = (v0[2] * c01[3] + v0[3] * c01[2]) * sc;
                        o1[0] = (v1[0] * c23[0] - v1[1] * c23[1]) * sc; o1[1] = (v1[0] * c23[1] + v1[1] * c23[0]) * sc;
                        o1[2] = (v1[2] * c23[2] - v1[3] * c23[3]) * sc; o1[3] = (v1[2] * c23[3] + v1[3] * c23[2]) * sc;
                        v0 = o0; v1 = o1;
                    } else if (MODE == 2) { v0 = v0 * QS_SCALE; v1 = v1 * QS_SCALE; }
                    else if (MODE == 4) {
#pragma unroll
                        for (int q = 0; q < 4; ++q) { v0[q] = v0[q] * fsigmoid(v0[q]); v1[q] = v1[q] * fsigmoid(v1[q]); }
                    } else if (MODE == 5) {
#pragma unroll
                        for (int q = 0; q < 4; ++q) { v0[q] = fsigmoid(v0[q]); v1[q] = fsigmoid(v1[q]); }
                    }
                    st8(rowp + bj * HALF, v0, v1);
                }
            }
    }
    __device__ __forceinline__ void operator()(const f32x4 (&acc)[2][2][4][2], const Unit& u, int wr, int wc, int fr, int fq) const {
        const int pn = u.pn, row0 = u.pm * BM + wr * 64 + fr, cw = wc * 32 + 8 * fq;
#ifdef PLAIN_NAT
        if (pn < 2)       body<3>(acc, QR, 512, row0, pn * BM + cw);
        else if (pn < 4)  body<3>(acc, KR, 512, row0, (pn - 2) * BM + cw);
        else if (pn < 6)  body<3>(acc, QS, 512, row0, (pn - 4) * BM + cw);
        else if (pn < 8)  body<3>(acc, KS, 512, row0, (pn - 6) * BM + cw);
        else if (pn < 12) body<3>(acc, GR, 1024, row0, (pn - 8) * BM + cw);
        else if (pn < 16) body<3>(acc, AR, 1024, row0, (pn - 12) * BM + cw);
        else              body<3>(acc, AS, 1024, row0, (pn - 16) * BM + cw);
        return;
#endif
        if (pn < 2)       body<0>(acc, QR, 512, row0, pn * BM + cw);
        else if (pn < 4)  body<1>(acc, KR, 512, row0, (pn - 2) * BM + cw);
        else if (pn < 6)  body<2>(acc, QS, 512, row0, (pn - 4) * BM + cw);
        else if (pn < 8)  body<3>(acc, KS, 512, row0, (pn - 6) * BM + cw);
        else if (pn < 12) body<4>(acc, GR, 1024, row0, (pn - 8) * BM + cw);
        else if (pn < 16) body<5>(acc, AR, 1024, row0, (pn - 12) * BM + cw);
        else              body<5>(acc, AS, 1024, row0, (pn - 16) * BM + cw);
    }
};

struct EpiProjTr {
    static constexpr bool PERM = true, AFTER_DRAIN = false;
    bf16_t *KRT, *VRT, *VST; const float* csT;
    __device__ __forceinline__ void operator()(const f32x4 (&acc)[2][2][4][2], const Unit& u, int wr, int wc, int fr, int fq) const {
        const int pm = u.pm, rf0 = pm * BM + wr * 64 + fr, tok0 = u.pn * BM + wc * 32 + 8 * fq;
#ifdef PLAIN_TR
        const bool rotp = false;
#else
        const bool rotp = pm < 2;
#endif
        if (rotp) {
#pragma unroll
            for (int ai = 0; ai < 2; ++ai)
#pragma unroll
                for (int m = 0; m < 4; ++m) {
                    const int rf = rf0 + ai * HALF + m * 16, h = rf >> 6, i = (rf & 63) >> 1;
                    const float sgn = (rf & 1) ? 1.0f : -1.0f, lg = log2gamma(h);
#pragma unroll
                    for (int bj = 0; bj < 2; ++bj) {
                        const int tok = tok0 + bj * HALF;
                        const f32x4 v0 = acc[ai][bj][m][0], v1 = acc[ai][bj][m][1];
                        const float* cp = csT + ((size_t)i * MTOKc + tok) * 2;
                        const f32x4 c0 = *(const f32x4*)(cp), c1 = *(const f32x4*)(cp + 4), c2 = *(const f32x4*)(cp + 8), c3 = *(const f32x4*)(cp + 12);
                        const float own[8] = {v0[0], v0[1], v0[2], v0[3], v1[0], v1[1], v1[2], v1[3]};
                        const float cc[8] = {c0[0], c0[2], c1[0], c1[2], c2[0], c2[2], c3[0], c3[2]};
                        const float ss[8] = {c0[1], c0[3], c1[1], c1[3], c2[1], c2[3], c3[1], c3[3]};
                        float o[8];
#pragma unroll
                        for (int q = 0; q < 8; ++q) {
                            const float oth = __shfl_xor(own[q], 1);
                            const float dec = 0.125f * __builtin_amdgcn_exp2f(lg * (float)(63 - ((tok & 63) + q)));
                            o[q] = (own[q] * cc[q] + sgn * oth * ss[q]) * dec;
                        }
                        st8(KRT + (size_t)rf * MTOKc + tok, (f32x4){o[0], o[1], o[2], o[3]}, (f32x4){o[4], o[5], o[6], o[7]});
                    }
                }
        } else {
            bf16_t* base = (pm < 2) ? KRT : (pm < 6) ? (VRT - (size_t)512 * MTOKc) : (VST - (size_t)1536 * MTOKc);
#pragma unroll
            for (int ai = 0; ai < 2; ++ai)
#pragma unroll
                for (int m = 0; m < 4; ++m) {
                    const int rf = rf0 + ai * HALF + m * 16;
#pragma unroll
                    for (int bj = 0; bj < 2; ++bj) st8(base + (size_t)rf * MTOKc + tok0 + bj * HALF, acc[ai][bj][m][0], acc[ai][bj][m][1]);
                }
        }
    }
};

template <bool SECOND> struct EpiMerge {
    static constexpr bool PERM = true, AFTER_DRAIN = false;
    const bf16_t* G; const bf16_t* T; bf16_t* O;
    __device__ __forceinline__ void operator()(const f32x4 (&acc)[2][2][4][2], const Unit& u, int wr, int wc, int fr, int fq) const {
        const int row0 = u.pm * BM + wr * 64 + fr, col0 = u.pn * BM + wc * 32 + 8 * fq;
#pragma unroll
        for (int ai = 0; ai < 2; ++ai)
#pragma unroll
            for (int m = 0; m < 4; ++m) {
                const size_t off = (size_t)(row0 + ai * HALF + m * 16) * 1024 + col0;
#pragma unroll
                for (int bj = 0; bj < 2; ++bj) {
                    const u32x4 g = *(const u32x4*)(G + off + bj * HALF);
                    f32x4 v0 = acc[ai][bj][m][0], v1 = acc[ai][bj][m][1];
                    v0[0] *= bflo(g.x); v0[1] *= bfhi(g.x); v0[2] *= bflo(g.y); v0[3] *= bfhi(g.y);
                    v1[0] *= bflo(g.z); v1[1] *= bfhi(g.z); v1[2] *= bflo(g.w); v1[3] *= bfhi(g.w);
                    if (SECOND) {
                        const u32x4 t = *(const u32x4*)(T + off + bj * HALF);
                        v0[0] += bflo(t.x); v0[1] += bfhi(t.x); v0[2] += bflo(t.y); v0[3] += bfhi(t.y);
                        v1[0] += bflo(t.z); v1[1] += bfhi(t.z); v1[2] += bflo(t.w); v1[3] += bfhi(t.w);
                    }
                    st8(O + off + bj * HALF, v0, v1);
                }
            }
    }
};

struct EpiF32 {
    static constexpr bool PERM = false, AFTER_DRAIN = false;
    float* O; int ldc;
    __device__ __forceinline__ void operator()(const f32x4 (&acc)[2][2][4][2], const Unit& u, int wr, int wc, int fr, int fq) const {
        const int row0 = u.pm * BM + wr * 64 + fr, col0 = u.pn * BM + wc * 32 + 4 * fq;
#pragma unroll
        for (int ai = 0; ai < 2; ++ai)
#pragma unroll
            for (int m = 0; m < 4; ++m) {
                float* rowp = O + (size_t)(row0 + ai * HALF + m * 16) * ldc + col0;
#pragma unroll
                for (int bj = 0; bj < 2; ++bj)
#pragma unroll
                    for (int n = 0; n < 2; ++n) *(f32x4*)(rowp + bj * HALF + n * 16) = acc[ai][bj][m][n];
            }
    }
};

template <int ACT  > struct EpiBf {
    static constexpr bool PERM = true, AFTER_DRAIN = false;
    bf16_t* O; int ldc;
    __device__ __forceinline__ void operator()(const f32x4 (&acc)[2][2][4][2], const Unit& u, int wr, int wc, int fr, int fq) const {
        const int row0 = u.pm * BM + wr * 64 + fr, col0 = u.pn * BM + wc * 32 + 8 * fq;
#pragma unroll
        for (int ai = 0; ai < 2; ++ai)
#pragma unroll
            for (int m = 0; m < 4; ++m) {
                bf16_t* rowp = O + (size_t)(row0 + ai * HALF + m * 16) * ldc + col0;
#pragma unroll
                for (int bj = 0; bj < 2; ++bj) {
                    f32x4 v0 = acc[ai][bj][m][0], v1 = acc[ai][bj][m][1];
                    if (ACT == 1) {
#pragma unroll
                        for (int q = 0; q < 4; ++q) { const float a = __builtin_fmaxf(v0[q], 0.f), b = __builtin_fmaxf(v1[q], 0.f); v0[q] = a * a; v1[q] = b * b; }
                    }
                    st8(rowp + bj * HALF, v0, v1);
                }
            }
    }
};
struct PanelStats {
    unsigned* xbuf;
    unsigned* cnt;
    unsigned* tmo;
    int ntn; float eps;
    unsigned code;
    __device__ __forceinline__ bool run(const f32x4 (&v)[2][2][4][2], const Unit& u, int wr, int wc, int fr, int fq, PG8_LAS unsigned char* lds, int wid, int lane) const {
        typedef float f32x2v __attribute__((ext_vector_type(2)));
        PG8_LAS f32x2v* P = (PG8_LAS f32x2v*)lds;
        PG8_LAS f32x2v* S = (PG8_LAS f32x2v*)(lds + 8192);
        PG8_LAS unsigned* flag = (PG8_LAS unsigned*)(lds + 8192 + 2048);
#pragma unroll
        for (int ai = 0; ai < 2; ++ai)
#pragma unroll
            for (int m = 0; m < 4; ++m) {
                float s = 0.f;
#pragma unroll
                for (int bj = 0; bj < 2; ++bj)
#pragma unroll
                    for (int n = 0; n < 2; ++n) { const f32x4 x = v[ai][bj][m][n]; s += (x[0] + x[1]) + (x[2] + x[3]); }
                s += __shfl_xor(s, 16); s += __shfl_xor(s, 32);
                const float mw = s * (1.0f / 64.0f); float q = 0.f;
#pragma unroll
                for (int bj = 0; bj < 2; ++bj)
#pragma unroll
                    for (int n = 0; n < 2; ++n) { const f32x4 d = v[ai][bj][m][n] - mw; q += (d[0] * d[0] + d[1] * d[1]) + (d[2] * d[2] + d[3] * d[3]); }
                q += __shfl_xor(q, 16); q += __shfl_xor(q, 32);
                if (fq == 0) P[(ai * HALF + wr * 64 + m * 16 + fr) * 4 + wc] = (f32x2v){mw, q};
            }
        asm volatile("s_waitcnt lgkmcnt(0)" ::: "memory"); __builtin_amdgcn_s_barrier(); asm volatile("" ::: "memory");
#if defined(BROKEN_EXCHANGE_NO_WAIT)
#warning BROKEN CONTROL BUILD: the row-statistics exchange does not wait; results are wrong by design
        if (blockIdx.x >= 64) { const long long t0_ = clock64(); while (clock64() - t0_ < 60000) __builtin_amdgcn_s_sleep(8); }
#endif
        const int row = wid * 32 + (lane & 31);
        if (lane < 32) {
            const f32x2v a = P[row * 4 + 0], b = P[row * 4 + 1], c = P[row * 4 + 2], d = P[row * 4 + 3];
            const float mt = (a.x + b.x + c.x + d.x) * 0.25f;
            const float da = a.x - mt, db = b.x - mt, dc = c.x - mt, dd = d.x - mt;
            const float m2 = (a.y + b.y) + (c.y + d.y) + 64.0f * ((da * da + db * db) + (dc * dc + dd * dd));
            unsigned long long* slot = (unsigned long long*)xbuf + ((size_t)(u.pm * BM + row) * 4 + u.pn);
            __hip_atomic_store(slot, ((unsigned long long)__float_as_uint(m2) << 32) | __float_as_uint(mt), __ATOMIC_RELAXED, __HIP_MEMORY_SCOPE_AGENT);
        }
        asm volatile("s_waitcnt vmcnt(0)" ::: "memory");
        if (lane == 0) __hip_atomic_fetch_add(cnt + 64 * u.pm, 1u, __ATOMIC_RELAXED, __HIP_MEMORY_SCOPE_AGENT);
        if (wid == 0) {
            bool dead = false; const unsigned long long t0 = __builtin_amdgcn_s_memrealtime(); const unsigned want = 8u * (unsigned)ntn;
            for (;;) {
#if defined(BROKEN_EXCHANGE_NO_WAIT)
                break;
#endif
                if ((unsigned)__builtin_amdgcn_readfirstlane(__hip_atomic_load(cnt + 64 * u.pm, __ATOMIC_RELAXED, __HIP_MEMORY_SCOPE_AGENT)) >= want) break;
                if (__builtin_amdgcn_s_memrealtime() - t0 > 2000000ull) {
                    if (lane == 0) { unsigned expect = 0u; __hip_atomic_compare_exchange_strong(tmo + 1, &expect, code | (unsigned)(u.pm & 0xff), __ATOMIC_RELAXED, __ATOMIC_RELAXED, __HIP_MEMORY_SCOPE_AGENT);
                                     __hip_atomic_store(tmo, 1u, __ATOMIC_RELAXED, __HIP_MEMORY_SCOPE_AGENT); }
                    dead = true; break; }
                __builtin_amdgcn_s_sleep(2);
            }
            __builtin_amdgcn_fence(__ATOMIC_ACQUIRE, "agent");
            if (lane == 0) flag[0] = dead ? 1u : 0u;
        }
        asm volatile("s_waitcnt vmcnt(0) lgkmcnt(0)" ::: "memory"); __builtin_amdgcn_s_barrier(); asm volatile("" ::: "memory");
        const bool bad = flag[0] != 0u;
        if (lane < 32) {
            const unsigned long long* slot = (const unsigned long long*)xbuf + (size_t)(u.pm * BM + row) * 4; float mt[4], m2[4]; float ms = 0.f;
#pragma unroll
            for (int t = 0; t < 4; ++t) { if (t < ntn) { const unsigned long long w = __hip_atomic_load(slot + t, __ATOMIC_RELAXED, __HIP_MEMORY_SCOPE_AGENT); mt[t] = __uint_as_float((unsigned)w); m2[t] = __uint_as_float((unsigned)(w >> 32)); } else { mt[t] = 0.f; m2[t] = 0.f; } ms += mt[t]; }
            const float mean = ms / (float)ntn; float q = 0.f;
#pragma unroll
            for (int t = 0; t < 4; ++t) if (t < ntn) { const float dm = mt[t] - mean; q += m2[t] + 256.0f * dm * dm; }
            S[row] = (f32x2v){mean, 1.0f / sqrtf(q / (256.0f * (float)ntn) + eps)};
        }
        asm volatile("s_waitcnt lgkmcnt(0)" ::: "memory"); __builtin_amdgcn_s_barrier(); asm volatile("" ::: "memory");
        return bad;
    }
};
template <class Epi, class Sched, bool ALIGN_EPI = false, bool SP2 = false>
__device__ __forceinline__ void gemm_phase(PG8_LAS unsigned char* lds, const Gemm g, const Sched& S, const Epi& E) {
    const int tid = threadIdx.x, wid = __builtin_amdgcn_readfirstlane(tid >> 6), lane = tid & 63, wr = wid >> 2, wc = wid & 3, fr = lane & 15, fq = lane >> 4;
    const int K = g.K, nt = K / BK;
    unsigned voffA[2], voffB[2];
#pragma unroll
    for (int i = 0; i < 2; ++i) { int R, C; stage_rc(tid * 16 + i * 8192, R, C); const int Rb = Epi::PERM ? ((R & ~31) + perm32(R & 31)) : R;
        voffA[i] = (unsigned)(R * K + C) * 2u; voffB[i] = (unsigned)(Rb * K + C) * 2u; }
    const size_t kstep = (size_t)(BK * 2);
    const size_t hstep = (size_t)HALF * K * 2;
    const size_t tstep = 2 * hstep;
    const unsigned ldsw = (unsigned)wid * 1024u;
    const int aoff = lds_byte(wr * 64 + fr, fq * 8), boff = lds_byte(wc * 32 + fr, fq * 8);
#define PG8_SA(b, h) (((b) * 2 + (h)) * HTB)
#define PG8_SB(b, h) ((4 + (b) * 2 + (h)) * HTB)
#define PG8_STAGE(bufoff, gbase, voff) do { _Pragma("unroll") for (int _i = 0; _i < 2; ++_i) \
        __builtin_amdgcn_global_load_lds((const unsigned*)((const char*)(gbase) + (voff)[_i]), (PG8_LAS unsigned*)(lds + (bufoff) + ldsw + _i * 8192), 16, 0, 0); } while (0)
#define PG8_LDA(dst, b, h) do { _Pragma("unroll") for (int m = 0; m < 4; ++m) _Pragma("unroll") for (int k = 0; k < 2; ++k) dst[m][k] = *(const PG8_LAS bf16x8*)(lds + PG8_SA(b, h) + aoff + m * 2048 + k * 1024); } while (0)
#define PG8_LDB(dst, b, h) do { _Pragma("unroll") for (int n = 0; n < 2; ++n) _Pragma("unroll") for (int k = 0; k < 2; ++k) dst[n][k] = *(const PG8_LAS bf16x8*)(lds + PG8_SB(b, h) + boff + n * 2048 + k * 1024); } while (0)
#define PG8_MMA(ai, bj, At, Bt) do { __builtin_amdgcn_s_setprio(1); _Pragma("unroll") for (int m = 0; m < 4; ++m) _Pragma("unroll") for (int n = 0; n < 2; ++n) _Pragma("unroll") for (int k = 0; k < 2; ++k) \
        acc[ai][bj][m][n] = __builtin_amdgcn_mfma_f32_16x16x32_bf16(Bt[n][k], At[m][k], acc[ai][bj][m][n], 0, 0, 0); __builtin_amdgcn_s_setprio(0); } while (0)
#define PG8_WAIT_V(n) asm volatile("s_waitcnt vmcnt(" #n ")" ::: "memory")
#define PG8_WAIT_L(n) asm volatile("s_waitcnt lgkmcnt(" #n ")" ::: "memory")
#define PG8_BAR __builtin_amdgcn_s_barrier()
#define PG8_SCHED __builtin_amdgcn_sched_barrier(0)
    Unit cur, nxt; int ui = 0;
    if (!S.next(0, cur)) return;
    f32x4 acc[2][2][4][2];
#pragma unroll
    for (int a = 0; a < 2; ++a)
#pragma unroll
        for (int b = 0; b < 2; ++b)
#pragma unroll
            for (int m = 0; m < 4; ++m)
#pragma unroll
                for (int n = 0; n < 2; ++n) acc[a][b][m][n] = (f32x4){0.f, 0.f, 0.f, 0.f};
    bf16x8 At[4][2], B0[2][2], B1[2][2];
    const char* cA = (const char*)g.A + (size_t)cur.pm * tstep; const char* cB = (const char*)g.Bt + (size_t)cur.pn * tstep;
    S.a_ready(cur);
    if constexpr (SP2) {
        PG8_STAGE(PG8_SB(0, 0), cB, voffB); PG8_STAGE(PG8_SB(0, 1), cB + hstep, voffB); PG8_STAGE(PG8_SA(0, 0), cA, voffA); PG8_STAGE(PG8_SA(0, 1), cA + hstep, voffA);
        if (wr == 1) PG8_BAR;
        PG8_WAIT_V(2); PG8_BAR;
        PG8_STAGE(PG8_SB(1, 0), cB + kstep, voffB); PG8_STAGE(PG8_SA(1, 0), cA + kstep, voffA); PG8_STAGE(PG8_SB(1, 1), cB + hstep + kstep, voffB);
        PG8_WAIT_V(6); PG8_BAR;
    } else {
        PG8_STAGE(PG8_SB(0, 0), cB, voffB); PG8_STAGE(PG8_SA(0, 0), cA, voffA); PG8_STAGE(PG8_SB(0, 1), cB + hstep, voffB); PG8_STAGE(PG8_SA(0, 1), cA + hstep, voffA);
        if (wr == 1) PG8_BAR;
        PG8_WAIT_V(4); PG8_BAR;
        PG8_STAGE(PG8_SB(1, 0), cB + kstep, voffB); PG8_STAGE(PG8_SA(1, 0), cA + kstep, voffA); PG8_STAGE(PG8_SB(1, 1), cB + hstep + kstep, voffB);
        PG8_WAIT_V(6); PG8_BAR;
    }
    for (;;) {
        const bool has_next = S.next(ui + 1, nxt);
        const char* nA = has_next ? (const char*)g.A + (size_t)nxt.pm * tstep : cA; const char* nB = has_next ? (const char*)g.Bt + (size_t)nxt.pn * tstep : cB;
        for (int t = 0; t < nt; t += 2) {
            const bool last = (t == nt - 2);
            const char* a1 = cA + (size_t)(t + 1) * kstep;
            const char* a2 = last ? nA : cA + (size_t)(t + 2) * kstep; const char* b2 = last ? nB : cB + (size_t)(t + 2) * kstep;
            const char* a3 = a2 + kstep; const char* b3 = b2 + kstep;
            if (last && has_next) S.a_ready(nxt);
            if constexpr (SP2) {
            PG8_LDB(B0, 0, 0); PG8_LDB(B1, 0, 1); PG8_SCHED; PG8_LDA(At, 0, 0); PG8_STAGE(PG8_SA(1, 1), a1 + hstep, voffA);
            PG8_WAIT_V(8); PG8_WAIT_L(0); PG8_BAR; PG8_MMA(0, 0, At, B0); PG8_MMA(0, 1, At, B1); PG8_BAR; PG8_SCHED;
            PG8_LDA(At, 0, 1); PG8_STAGE(PG8_SB(0, 0), b2, voffB); PG8_STAGE(PG8_SB(0, 1), b2 + hstep, voffB); PG8_STAGE(PG8_SA(0, 0), a2, voffA);
            PG8_WAIT_V(8); PG8_WAIT_L(0); PG8_BAR; PG8_MMA(1, 0, At, B0); PG8_MMA(1, 1, At, B1); PG8_BAR; PG8_SCHED;
            PG8_LDB(B0, 1, 0); PG8_LDB(B1, 1, 1); PG8_SCHED; PG8_LDA(At, 1, 0); PG8_STAGE(PG8_SA(0, 1), a2 + hstep, voffA);
            PG8_WAIT_V(8); PG8_WAIT_L(0); PG8_BAR; PG8_MMA(0, 0, At, B0); PG8_MMA(0, 1, At, B1); PG8_BAR; PG8_SCHED;
            PG8_LDA(At, 1, 1); PG8_STAGE(PG8_SB(1, 0), b3, voffB); PG8_STAGE(PG8_SB(1, 1), b3 + hstep, voffB); PG8_STAGE(PG8_SA(1, 0), a3, voffA);
            PG8_WAIT_V(8); PG8_WAIT_L(0); PG8_BAR; PG8_MMA(1, 0, At, B0); PG8_MMA(1, 1, At, B1); PG8_BAR; PG8_SCHED;
            } else {
            PG8_LDB(B0, 0, 0); PG8_SCHED; PG8_LDA(At, 0, 0); PG8_STAGE(PG8_SA(1, 1), a1 + hstep, voffA);
            PG8_WAIT_L(8); PG8_BAR; PG8_WAIT_L(0); PG8_MMA(0, 0, At, B0); PG8_BAR; PG8_SCHED;
            PG8_LDB(B1, 0, 1); PG8_STAGE(PG8_SB(0, 0), b2, voffB);
            PG8_BAR; PG8_WAIT_L(0); PG8_MMA(0, 1, At, B1); PG8_BAR;
            PG8_LDA(At, 0, 1); PG8_STAGE(PG8_SA(0, 0), a2, voffA);
            PG8_BAR; PG8_WAIT_L(0); PG8_MMA(1, 0, At, B0); PG8_BAR; PG8_SCHED;
            PG8_STAGE(PG8_SB(0, 1), b2 + hstep, voffB);
            PG8_WAIT_V(6); PG8_BAR; PG8_MMA(1, 1, At, B1); PG8_BAR;
            PG8_LDB(B0, 1, 0); PG8_SCHED; PG8_LDA(At, 1, 0); PG8_STAGE(PG8_SA(0, 1), a2 + hstep, voffA);
            PG8_WAIT_L(8); PG8_BAR; PG8_WAIT_L(0); PG8_MMA(0, 0, At, B0); PG8_BAR; PG8_SCHED;
            PG8_LDB(B1, 1, 1); PG8_STAGE(PG8_SB(1, 0), b3, voffB);
            PG8_BAR; PG8_WAIT_L(0); PG8_MMA(0, 1, At, B1); PG8_BAR;
            PG8_LDA(At, 1, 1); PG8_STAGE(PG8_SA(1, 0), a3, voffA);
            PG8_BAR; PG8_WAIT_L(0); PG8_MMA(1, 0, At, B0); PG8_BAR; PG8_SCHED;
            PG8_STAGE(PG8_SB(1, 1), b3 + hstep, voffB);
            PG8_WAIT_V(6); PG8_BAR; PG8_MMA(1, 1, At, B1); PG8_BAR;
            }
        }
        if constexpr (ALIGN_EPI) { if (wr == 0) PG8_BAR; }
        if constexpr (!Epi::AFTER_DRAIN) { E(acc, cur, wr, wc, fr, fq); S.done(cur); }
        if (!has_next) break;
#pragma unroll
        for (int a = 0; a < 2; ++a)
#pragma unroll
            for (int b = 0; b < 2; ++b)
#pragma unroll
                for (int m = 0; m < 4; ++m)
#pragma unroll
                    for (int n = 0; n < 2; ++n) acc[a][b][m][n] = (f32x4){0.f, 0.f, 0.f, 0.f};
        cur = nxt; cA = nA; cB = nB; ++ui;
        if constexpr (ALIGN_EPI) { if (wr == 1) PG8_BAR; }
    }
    PG8_WAIT_V(0);
    if constexpr (!ALIGN_EPI) { if (wr == 0) PG8_BAR; }
    PG8_BAR;
    if constexpr (Epi::AFTER_DRAIN) { E.fused(acc, cur, wr, wc, fr, fq, lds, wid, lane); S.done(cur); }
#undef PG8_SA
#undef PG8_SB
#undef PG8_STAGE
#undef PG8_LDA
#undef PG8_LDB
#undef PG8_MMA
#undef PG8_WAIT_V
#undef PG8_WAIT_L
#undef PG8_BAR
#undef PG8_SCHED
}
}
#define GAS __attribute__((address_space(1)))
#define LAS __attribute__((address_space(3)))
typedef unsigned short bf16;
typedef unsigned v4u __attribute__((ext_vector_type(4)));
typedef float f32x4 __attribute__((ext_vector_type(4)));
typedef short bf16x8 __attribute__((ext_vector_type(8)));
typedef GAS unsigned gu32;
typedef GAS unsigned long long gu64;
#define RLX_AGENT __ATOMIC_RELAXED, __HIP_MEMORY_SCOPE_AGENT
#define LDS_WAIT() asm volatile("s_waitcnt lgkmcnt(0)" ::: "memory")
#define VM_WAIT() asm volatile("s_waitcnt vmcnt(0)" ::: "memory")
__device__ __forceinline__ unsigned long long rt() { return __builtin_amdgcn_s_memrealtime(); }
__device__ __forceinline__ unsigned f2bf(float f) { unsigned u = __builtin_bit_cast(unsigned, f); return (u + 0x7fffu + ((u >> 16) & 1u)) >> 16; }
__device__ __forceinline__ unsigned pk2(float lo, float hi) { return f2bf(lo) | (f2bf(hi) << 16); }

#define XB_TMO      128
#define XB_XCNT(j)  (256  + 64 * (j))
#define XB_XSUB(j)  (1280 + 64 * (j))
#define XB_XGEN(j)  (2304 + 64 * (j))
#define XB_TOP      3328
#define XB_TOPGEN   3392
#define XCD_BAR_WORDS 3456
#define XB_SPIN_CAP (1u << 18)

__device__ __forceinline__ unsigned xb_ld(unsigned* p)              { return __hip_atomic_load(p, __ATOMIC_RELAXED, __HIP_MEMORY_SCOPE_AGENT); }
__device__ __forceinline__ unsigned xb_add(unsigned* p, unsigned v) { return __hip_atomic_fetch_add(p, v, __ATOMIC_RELAXED, __HIP_MEMORY_SCOPE_AGENT); }
__device__ __forceinline__ unsigned xb_xcc_id() { return (unsigned)__builtin_amdgcn_s_getreg((3 << 11) | 20) & 0xFu; }
#define XB_SPIN(cond, bar) do { unsigned _sp = 0; while (cond) { __builtin_amdgcn_s_sleep(1); \
    if ((++_sp & 255u) == 0u) { if (xb_ld(&(bar)[XB_TMO])) break; if (_sp > XB_SPIN_CAP) { atomicAdd(&(bar)[XB_TMO], 1u); break; } } } } while (0)

struct XcdBarrier {
    unsigned* bar; unsigned x;
    volatile LAS unsigned* st;
};

__device__ __forceinline__ XcdBarrier xcd_barrier_post(unsigned* bar, volatile LAS unsigned* st) {
    XcdBarrier b; b.bar = bar; b.x = xb_xcc_id(); b.st = st;
    if (threadIdx.x == 0) (void)xb_add(&bar[XB_XCNT(b.x)], 1u);
    return b;
}
__device__ __forceinline__ void xcd_barrier_complete(unsigned* bar, unsigned x, unsigned& nloc, unsigned& nx) {
    const unsigned G = gridDim.x * gridDim.y * gridDim.z;
    unsigned sum, cnt, mine, sp = 0u;
    for (;;) {
        sum = 0u; cnt = 0u; mine = 0u;
#pragma unroll
        for (unsigned j = 0; j < 16; ++j) { const unsigned c = xb_ld(&bar[XB_XCNT(j)]); sum += c; cnt += (c > 0u) ? 1u : 0u; mine = (j == x) ? c : mine; }
        if (sum == G) break;
        __builtin_amdgcn_s_sleep(1);
        if ((++sp & 255u) == 0u) { if (xb_ld(&bar[XB_TMO])) break; if (sp > XB_SPIN_CAP) { atomicAdd(&bar[XB_TMO], 1u); break; } }
    }
    nloc = mine > 0u ? mine : 1u; nx = cnt > 0u ? cnt : 1u;
}

__device__ __forceinline__ void xcd_barrier(const XcdBarrier& b) {
    asm volatile("s_waitcnt vmcnt(0)" ::: "memory");
    __syncthreads();
    if (threadIdx.x == 0) {
        unsigned* bar = b.bar;
        __builtin_amdgcn_s_waitcnt(0);
        unsigned nloc = b.st[0], nx = b.st[1];
        if (nloc == 0u) { xcd_barrier_complete(bar, b.x, nloc, nx); b.st[0] = nloc; b.st[1] = nx; }
        const unsigned old = xb_add(&bar[XB_XSUB(b.x)], 1u);
        const unsigned gen = old / nloc;
        if (old + 1u == (gen + 1u) * nloc) {
            __builtin_amdgcn_fence(__ATOMIC_RELEASE, "agent");
            asm volatile("s_waitcnt vmcnt(0)" ::: "memory");
            const unsigned og = xb_add(&bar[XB_TOP], 1u);
            const unsigned tg = og / nx;
            if (og + 1u == (tg + 1u) * nx) xb_add(&bar[XB_TOPGEN], 1u);
            else XB_SPIN(xb_ld(&bar[XB_TOPGEN]) == tg, bar);
            __builtin_amdgcn_fence(__ATOMIC_ACQUIRE, "agent");
            xb_add(&bar[XB_XGEN(b.x)], 1u);
            asm volatile("s_waitcnt vmcnt(0)" ::: "memory");
        } else {
            XB_SPIN(xb_ld(&bar[XB_XGEN(b.x)]) == gen, bar);
            __builtin_amdgcn_fence(__ATOMIC_ACQUIRE, "agent");
            asm volatile("s_waitcnt vmcnt(0)" ::: "memory");
        }
    }
    __syncthreads();
}
typedef float f32x2v __attribute__((ext_vector_type(2)));

constexpr int NWAVES = 8;
constexpr int BATCH = 8, SEQ = 2048, DM = 1024, MTOK = BATCH * SEQ, DFF = 4096, DIN = 6656, NMOD = 6 * DM;
constexpr float RMS_EPS = 1e-6f;
#ifndef MK_N_LAUNCHES
#define MK_N_LAUNCHES 10
#endif
constexpr int NPH = 10;
constexpr int N_LAUNCHES = MK_N_LAUNCHES;

constexpr size_t MiB = 1u << 20;
constexpr size_t WS_CTL = 0, CTL_ZERO_BYTES = 2 * MiB;
constexpr size_t WS_MOD = 1 * MiB;
constexpr size_t WS_X = 2 * MiB;
constexpr size_t WS_CS = 4 * MiB, WS_CST = 8 * MiB;
constexpr size_t WS_WNAT = 12 * MiB, WS_WTR = 22 * MiB, WS_WRET = 26 * MiB, WS_WSB = 28 * MiB, WS_WOUT = 29 * MiB, WS_WFF1 = 31 * MiB, WS_WFF2 = 39 * MiB;
constexpr size_t WS_H = 47 * MiB;
constexpr size_t WS_QR = 79 * MiB, WS_KR = 95 * MiB;
constexpr size_t WS_QS = 111 * MiB, WS_KS = 127 * MiB;
constexpr size_t WS_GR = 143 * MiB, WS_KRT = 175 * MiB, WS_VRT = 191 * MiB, WS_VST = 223 * MiB, WS_SB = 239 * MiB, WS_END = 255 * MiB;
constexpr size_t WS_MIX = 79 * MiB, WS_T = 111 * MiB, WS_Y = 111 * MiB  , WS_U = 79 * MiB  , WS_F = 207 * MiB  ;
constexpr int CW_TMO = 0, CW_CODE = 1, CW_BAR = 4096, CW_SEAM = 16384, SEAM_BANK = 128 * 64;

constexpr int RING_OFF = 0, RING_BYTES = 131072;
constexpr int LDSCTL_OFF = RING_BYTES, MISC_OFF = LDSCTL_OFF + 320;
constexpr int LDS_BYTES = 147456;

__device__ __forceinline__ float bf2f(bf16 v) { return __builtin_bit_cast(float, (unsigned)v << 16); }
__device__ __forceinline__ float wave_sum(float v) {
#pragma unroll
    for (int o = 1; o < 64; o <<= 1) v += __shfl_xor(v, o);
    return v;
}

struct Frame {
    LAS unsigned char* lds;
    volatile LAS unsigned* MISC;
    gu32* ctl;
    int tid, lane, wave, G;
    const float *x, *c, *ada_w, *ada_b, *pre_mix_g, *post_mix_g, *pre_ffn_g, *post_ffn_g, *w_in, *ret_gn_g, *w_ret, *w_sb, *w_out, *w_ff1, *w_ff2;
    const int* positions;
    float* out; unsigned char* ws;
};

struct MapNat { __device__ __forceinline__ int operator()(int r) const {
    if (r < 1024) { const int rr = r & 511, h = rr >> 6, rem = rr & 63; return (r & 512) + h * 64 + (rem >> 1) + 32 * (rem & 1); }
    if (r < 1536) return 3072 + (r - 1024);
    if (r < 2048) return 3584 + (r - 1536);
    if (r < 3072) return r;
    if (r < 4096) return 4608 + (r - 3072);
    return 5632 + (r - 4096); } };
struct MapTr { __device__ __forceinline__ int operator()(int r) const {
    if (r < 512) { const int h = r >> 6, rem = r & 63; return 512 + h * 64 + (rem >> 1) + 32 * (rem & 1); }
    if (r < 1536) return 1024 + (r - 512);
    return 4096 + (r - 1536); } };
struct MapId { __device__ __forceinline__ int operator()(int r) const { return r; } };

template <class Map> __device__ __forceinline__ void transpose_item(const float* W, int Nsrc, int K, bf16* WT, LAS float* scr, int item, int nblk, int lane, Map map) {
    const int kb = item / nblk, nb = item % nblk, k0 = 64 * kb, n0 = 32 * nb;
    const int sc = map(n0 + (lane & 31));
#pragma unroll 8
    for (int i = 0; i < 32; ++i) { const int kk = 2 * i + (lane >> 5); scr[kk * 33 + (lane & 31)] = W[(size_t)(k0 + kk) * Nsrc + sc]; }
    LDS_WAIT(); asm volatile("" ::: "memory");
    const int c = lane & 7;
#pragma unroll
    for (int j = 0; j < 4; ++j) { const int n = (lane >> 3) + 8 * j; const LAS float* s = scr + (8 * c) * 33 + n;
        v4u o; o.x = pk2(s[0 * 33], s[1 * 33]); o.y = pk2(s[2 * 33], s[3 * 33]); o.z = pk2(s[4 * 33], s[5 * 33]); o.w = pk2(s[6 * 33], s[7 * 33]);
        *(GAS v4u*)(WT + (size_t)(n0 + n) * K + k0 + 8 * c) = o; }
    LDS_WAIT(); asm volatile("" ::: "memory");
}

__device__ __forceinline__ void p0_mod(Frame& F) {
    LAS float* red = (LAS float*)(F.lds + RING_OFF);
    float* mod = (float*)(F.ws + WS_MOD);
    for (int item = blockIdx.x; item < 256; item += F.G) {
        const int cq = F.tid & 7, rl = F.tid >> 3;
        if (cq < 6) {
            f32x4 acc[8];
#pragma unroll
            for (int b = 0; b < 8; ++b) acc[b] = (f32x4){0.f, 0.f, 0.f, 0.f};
#pragma unroll 4
            for (int i = 0; i < 16; ++i) {
                const int k = rl + 64 * i;
                const f32x4 w = *(const f32x4*)(F.ada_w + (size_t)k * NMOD + item * 24 + cq * 4);
#pragma unroll
                for (int b = 0; b < 8; ++b) { const float cv = F.c[b * DM + k]; acc[b] += w * (cv * pg8::fsigmoid(cv)); }
            }
#pragma unroll
            for (int b = 0; b < 8; ++b) *(LAS f32x4*)(red + (rl * 8 + b) * 24 + cq * 4) = acc[b];
        }
        __syncthreads();
        if (F.tid < 192) { const int b = F.tid / 24, col = F.tid % 24; float s = 0.f;
            for (int r2 = 0; r2 < 64; ++r2) s += red[(r2 * 8 + b) * 24 + col];
            mod[b * NMOD + item * 24 + col] = s + F.ada_b[item * 24 + col]; }
        __syncthreads();
    }
}

__device__ __forceinline__ void rot_cs(int pos, int i, float& c, float& s) {
    const float invf = (float)exp2(-(double)i * (13.287712379549449 / 32.0));
    const float ang = (float)pos * invf;
    const double turns = (double)ang * 0.15915494309189535;
    const float fr = (float)(turns - rint(turns));
    c = __builtin_amdgcn_cosf(fr); s = __builtin_amdgcn_sinf(fr);
}

__device__ __forceinline__ void p0_prologue(Frame& F) {
    p0_mod(F);
    __syncthreads();
    LAS float* scr = (LAS float*)(F.lds + RING_OFF + F.wave * 16384);
    const int gw = blockIdx.x * NWAVES + F.wave, NGW = F.G * NWAVES;
    bf16* Wnat = (bf16*)(F.ws + WS_WNAT); bf16* Wtr = (bf16*)(F.ws + WS_WTR); bf16* Wret = (bf16*)(F.ws + WS_WRET); bf16* Wsb = (bf16*)(F.ws + WS_WSB);
    bf16* Wout = (bf16*)(F.ws + WS_WOUT); bf16* Wff1 = (bf16*)(F.ws + WS_WFF1); bf16* Wff2 = (bf16*)(F.ws + WS_WFF2);
    constexpr int I_NAT = 16 * 160, I_TR = 16 * 64, I_RET = 16 * 32, I_SB = 8 * 32, I_OUT = 16 * 32, I_FF1 = 16 * 128, I_FF2 = 64 * 32;
    constexpr int NITEMS = I_NAT + I_TR + I_RET + I_SB + I_OUT + I_FF1 + I_FF2;
    for (int it = gw; it < NITEMS; it += NGW) {
        int r = it;
        if (r < I_NAT) { transpose_item(F.w_in, DIN, DM, Wnat, scr, r, 160, F.lane, MapNat()); continue; } r -= I_NAT;
        if (r < I_TR)  { transpose_item(F.w_in, DIN, DM, Wtr, scr, r, 64, F.lane, MapTr()); continue; } r -= I_TR;
        if (r < I_RET) { transpose_item(F.w_ret, DM, DM, Wret, scr, r, 32, F.lane, MapId()); continue; } r -= I_RET;
        if (r < I_SB)  { transpose_item(F.w_sb, DM, 512, Wsb, scr, r, 32, F.lane, MapId()); continue; } r -= I_SB;
        if (r < I_OUT) { transpose_item(F.w_out, DM, DM, Wout, scr, r, 32, F.lane, MapId()); continue; } r -= I_OUT;
        if (r < I_FF1) { transpose_item(F.w_ff1, DFF, DM, Wff1, scr, r, 128, F.lane, MapId()); continue; } r -= I_FF1;
        transpose_item(F.w_ff2, DM, DFF, Wff2, scr, r, 32, F.lane, MapId());
    }
    float* cs = (float*)(F.ws + WS_CS); float* csT = (float*)(F.ws + WS_CST);
    const int gt = blockIdx.x * (NWAVES * 64) + F.tid, NGT = F.G * NWAVES * 64;
    for (int idx = gt; idx < MTOK * 32; idx += NGT) { const int tok = idx >> 5, i = idx & 31; float c, s; rot_cs(F.positions[tok], i, c, s); *(f32x2v*)(cs + (size_t)idx * 2) = (f32x2v){c, s}; }
    for (int idx = gt; idx < MTOK * 32; idx += NGT) { const int i = idx >> 14, tok = idx & (MTOK - 1); float c, s; rot_cs(F.positions[tok], i, c, s); *(f32x2v*)(csT + (size_t)idx * 2) = (f32x2v){c, s}; }
}

__device__ __forceinline__ unsigned long long pk4(float a, float b, float c, float d) { return (unsigned long long)pk2(a, b) | ((unsigned long long)pk2(c, d) << 32); }
__device__ __forceinline__ void p1_rows(Frame& F) {
    const int gw = blockIdx.x * NWAVES + F.wave, NGW = F.G * NWAVES;
    const float* mod = (const float*)(F.ws + WS_MOD); bf16* H = (bf16*)(F.ws + WS_H);
    for (int m = gw; m < MTOK; m += NGW) {
        const int b = m >> 11;
        const GAS f32x4* xr = (const GAS f32x4*)(F.x + (size_t)m * DM) + F.lane;
        f32x4 v[4]; float ss = 0.f;
#pragma unroll
        for (int j = 0; j < 4; ++j) { v[j] = xr[64 * j]; ss += (v[j].x * v[j].x + v[j].y * v[j].y) + (v[j].z * v[j].z + v[j].w * v[j].w); }
        const float rstd = 1.0f / sqrtf(wave_sum(ss) * (1.0f / DM) + RMS_EPS);
        GAS unsigned long long* o8 = (GAS unsigned long long*)(H + (size_t)m * DM) + F.lane;
#pragma unroll
        for (int j = 0; j < 4; ++j) {
            const int col = 4 * F.lane + 256 * j;
            const f32x4 g = *(const f32x4*)(F.pre_mix_g + col), sh = *(const f32x4*)(mod + b * NMOD + col), sc = *(const f32x4*)(mod + b * NMOD + DM + col);
            const f32x4 o = (v[j] * rstd) * g * (sc + 1.0f) + sh;
            o8[64 * j] = pk4(o.x, o.y, o.z, o.w);
        }
    }
}

__device__ __forceinline__ void p6_rows(Frame& F) {
    const int gw = blockIdx.x * NWAVES + F.wave, NGW = F.G * NWAVES;
    const float* mod = (const float*)(F.ws + WS_MOD); const float* Y = (const float*)(F.ws + WS_Y); bf16* H2 = (bf16*)(F.ws + WS_H);
    for (int m = gw; m < MTOK; m += NGW) {
        const int b = m >> 11;
        const GAS f32x4* yr = (const GAS f32x4*)(Y + (size_t)m * DM) + F.lane;
        const GAS f32x4* xr = (const GAS f32x4*)(F.x + (size_t)m * DM) + F.lane;
        f32x4 v[4]; float ss = 0.f;
#pragma unroll
        for (int j = 0; j < 4; ++j) { v[j] = yr[64 * j]; ss += (v[j].x * v[j].x + v[j].y * v[j].y) + (v[j].z * v[j].z + v[j].w * v[j].w); }
        const float rstd1 = 1.0f / sqrtf(wave_sum(ss) * (1.0f / DM) + RMS_EPS);
        float s2 = 0.f;
        GAS f32x4* orow = (GAS f32x4*)(F.out + (size_t)m * DM) + F.lane;
#pragma unroll
        for (int j = 0; j < 4; ++j) {
            const int col = 4 * F.lane + 256 * j;
            const f32x4 g = *(const f32x4*)(F.post_mix_g + col), gt = *(const f32x4*)(mod + b * NMOD + 2 * DM + col);
            v[j] = xr[64 * j] + gt * ((v[j] * rstd1) * g);
            orow[64 * j] = v[j];
            s2 += (v[j].x * v[j].x + v[j].y * v[j].y) + (v[j].z * v[j].z + v[j].w * v[j].w);
        }
        const float rstd2 = 1.0f / sqrtf(wave_sum(s2) * (1.0f / DM) + RMS_EPS);
        GAS unsigned long long* o8 = (GAS unsigned long long*)(H2 + (size_t)m * DM) + F.lane;
#pragma unroll
        for (int j = 0; j < 4; ++j) {
            const int col = 4 * F.lane + 256 * j;
            const f32x4 g = *(const f32x4*)(F.pre_ffn_g + col), sh = *(const f32x4*)(mod + b * NMOD + 3 * DM + col), sc = *(const f32x4*)(mod + b * NMOD + 4 * DM + col);
            const f32x4 o = (v[j] * rstd2) * g * (sc + 1.0f) + sh;
            o8[64 * j] = pk4(o.x, o.y, o.z, o.w);
        }
    }
}
__device__ __forceinline__ void p9_rows(Frame& F) {
    const int gw = blockIdx.x * NWAVES + F.wave, NGW = F.G * NWAVES;
    const float* mod = (const float*)(F.ws + WS_MOD); const bf16* Fb = (const bf16*)(F.ws + WS_F);
    for (int m = gw; m < MTOK; m += NGW) {
        const int b = m >> 11;
        const GAS unsigned long long* fr = (const GAS unsigned long long*)(Fb + (size_t)m * DM) + F.lane;
        f32x4 v[4]; float ss = 0.f;
#pragma unroll
        for (int j = 0; j < 4; ++j) { const unsigned long long w = fr[64 * j]; const unsigned lo = (unsigned)w, hi = (unsigned)(w >> 32);
            v[j] = (f32x4){pg8::bflo(lo), pg8::bfhi(lo), pg8::bflo(hi), pg8::bfhi(hi)};
            ss += (v[j].x * v[j].x + v[j].y * v[j].y) + (v[j].z * v[j].z + v[j].w * v[j].w); }
        const float rstd = 1.0f / sqrtf(wave_sum(ss) * (1.0f / DM) + RMS_EPS);
        GAS f32x4* orow = (GAS f32x4*)(F.out + (size_t)m * DM) + F.lane;
#pragma unroll
        for (int j = 0; j < 4; ++j) {
            const int col = 4 * F.lane + 256 * j;
            const f32x4 g = *(const f32x4*)(F.post_ffn_g + col), gt = *(const f32x4*)(mod + b * NMOD + 5 * DM + col);
            orow[64 * j] = orow[64 * j] + gt * ((v[j] * rstd) * g);
        }
    }
}

__device__ __forceinline__ void naive_retention(Frame& F, int bh) {
    const int b = bh >> 3, h = bh & 7, tid = F.tid, lane = F.lane, wave = F.wave;
    const float lg = pg8::log2gamma(h);
    LAS float* S = (LAS float*)(F.lds);
    LAS float* qL = S + 64 * 128;
    LAS float* kL = qL + 64 * 65;
    LAS float* sL = kL + 64 * 65;
    LAS float* vL = sL + 64 * 65;
    LAS float* st = vL + 64 * 128;
    const bf16* QR = (const bf16*)(F.ws + WS_QR); const bf16* KR = (const bf16*)(F.ws + WS_KR); const bf16* KRT = (const bf16*)(F.ws + WS_KRT);
    const bf16* VRT = (const bf16*)(F.ws + WS_VRT); const bf16* GR = (const bf16*)(F.ws + WS_GR); bf16* RG = (bf16*)(F.ws + WS_H);
    for (int i = tid; i < 64 * 128; i += 512) S[i] = 0.f;
    const float g64 = __builtin_amdgcn_exp2f(lg * 64.0f);
    for (int n = 0; n < 32; ++n) {
        const int tok0 = b * SEQ + n * 64;
        __syncthreads();
        for (int r = 0; r < 8; ++r) { const int idx = tid + 512 * r, i = idx >> 6, d = idx & 63;
            qL[i * 65 + d] = bf2f(QR[(size_t)(tok0 + i) * 512 + h * 64 + d]); kL[i * 65 + d] = bf2f(KR[(size_t)(tok0 + i) * 512 + h * 64 + d]); }
        for (int r = 0; r < 16; ++r) { const int idx = tid + 512 * r, e = idx >> 6, j = idx & 63; vL[j * 128 + e] = bf2f(VRT[(size_t)(h * 128 + e) * MTOK + tok0 + j]); }
        __syncthreads();
        for (int r = 0; r < 8; ++r) { const int idx = tid + 512 * r, i = idx >> 6, j = idx & 63; float s = 0.f;
            for (int d = 0; d < 64; ++d) s += qL[i * 65 + d] * kL[j * 65 + d];
            const int dist = i > j ? i - j : j - i;
            sL[i * 65 + j] = s * __builtin_amdgcn_exp2f(lg * (float)dist); }
        __syncthreads();
        const int e = tid & 127, ig = tid >> 7;
        float rv[16];
#pragma unroll
        for (int kq = 0; kq < 16; ++kq) { const int i = ig + 4 * kq; float intra = 0.f, cross = 0.f;
            for (int j = 0; j < 64; ++j) intra += sL[i * 65 + j] * vL[j * 128 + e];
            for (int d = 0; d < 64; ++d) cross += qL[i * 65 + d] * S[d * 128 + e];
            rv[kq] = intra + __builtin_amdgcn_exp2f(lg * (float)(i + 1)) * cross; }
#pragma unroll
        for (int kq = 0; kq < 16; ++kq) { const float s1 = wave_sum(rv[kq]); if (lane == 0) st[(ig + 4 * kq) * 4 + (wave & 1)] = s1; }
        __syncthreads();
#pragma unroll
        for (int kq = 0; kq < 16; ++kq) { const int i = ig + 4 * kq; const float mu = (st[i * 4] + st[i * 4 + 1]) * (1.0f / 128.0f); rv[kq] -= mu;
            const float s2 = wave_sum(rv[kq] * rv[kq]); if (lane == 0) st[i * 4 + 2 + (wave & 1)] = s2; }
        __syncthreads();
#pragma unroll
        for (int kq = 0; kq < 16; ++kq) { const int i = ig + 4 * kq; const float var = (st[i * 4 + 2] + st[i * 4 + 3]) * (1.0f / 128.0f);
            const float o = rv[kq] * (1.0f / sqrtf(var + RMS_EPS)) * F.ret_gn_g[h * 128 + e] * bf2f(GR[(size_t)(tok0 + i) * DM + h * 128 + e]);
            RG[(size_t)(tok0 + i) * DM + h * 128 + e] = (bf16)f2bf(o); }
#pragma unroll 4
        for (int kq = 0; kq < 16; ++kq) { const int d = ig + 4 * kq; float a = 0.f;
            const bf16* kp = KRT + (size_t)(h * 64 + d) * MTOK + tok0;
            for (int j = 0; j < 64; ++j) a += bf2f(kp[j]) * vL[j * 128 + e];
            S[d * 128 + e] = S[d * 128 + e] * g64 + a; }
    }
    __syncthreads();
}

__device__ __forceinline__ void naive_sb_row(Frame& F, int ri) {
    const int lane = F.lane;
    const int t = ri & (SEQ - 1), bh = ri >> 11, b = bh >> 3, h = bh & 7;
    const bf16* QS = (const bf16*)(F.ws + WS_QS); const bf16* KS = (const bf16*)(F.ws + WS_KS); const bf16* VST = (const bf16*)(F.ws + WS_VST); bf16* SB = (bf16*)(F.ws + WS_SB);
    LAS float* qL = (LAS float*)(F.lds) + F.wave * 64;
    qL[lane] = bf2f(QS[(size_t)(b * SEQ + t) * 512 + h * 64 + lane]);
    LDS_WAIT(); asm volatile("" ::: "memory");
    float acc[64];
#pragma unroll
    for (int d = 0; d < 64; ++d) acc[d] = 0.f;
    float R = 0.f;
    for (int sb = (t - 1) >> 6; sb >= 0; --sb) {
        const int s = sb * 64 + lane; const bool valid = s < t;
        const v4u* kp = (const v4u*)(KS + (size_t)(b * SEQ + s) * 512 + h * 64);
        float z = 0.f;
#pragma unroll
        for (int c8 = 0; c8 < 8; ++c8) { const v4u w = kp[c8];
            z += qL[c8 * 8 + 0] * pg8::bflo(w.x) + qL[c8 * 8 + 1] * pg8::bfhi(w.x) + qL[c8 * 8 + 2] * pg8::bflo(w.y) + qL[c8 * 8 + 3] * pg8::bfhi(w.y)
               + qL[c8 * 8 + 4] * pg8::bflo(w.z) + qL[c8 * 8 + 5] * pg8::bfhi(w.z) + qL[c8 * 8 + 6] * pg8::bflo(w.w) + qL[c8 * 8 + 7] * pg8::bfhi(w.w); }
        const float ez = __builtin_amdgcn_exp2f(-__builtin_fabsf(z)), l = __builtin_amdgcn_logf(1.0f + ez);
        const float sp = valid ? __builtin_fmaxf(z, 0.f) + l : 0.f;
        float incl = sp;
#pragma unroll
        for (int off = 1; off < 64; off <<= 1) { const float v = __shfl_down(incl, off); if (lane + off < 64) incl += v; }
        const float total = __shfl(incl, 0);
        const float a = valid ? __builtin_amdgcn_exp2f(__builtin_fminf(z, 0.f) - l - ((incl - sp) + R)) : 0.f;
        R += total;
        const bf16* vp = VST + (size_t)(h * 64) * MTOK + b * SEQ + s;
#pragma unroll
        for (int d = 0; d < 64; ++d) acc[d] += a * bf2f(vp[(size_t)d * MTOK]);
    }
    float outv = 0.f;
#pragma unroll
    for (int d = 0; d < 64; ++d) { const float s = wave_sum(acc[d]); if (lane == d) outv = s; }
    SB[(size_t)(b * SEQ + t) * 512 + h * 64 + lane] = (bf16)f2bf(outv);
    LDS_WAIT(); asm volatile("" ::: "memory");
}

__device__ __forceinline__ void p3_mixers_naive(Frame& F) {
#ifdef KO_MIXERS
    { const bf16* GR = (const bf16*)(F.ws + WS_GR); const bf16* QS = (const bf16*)(F.ws + WS_QS); bf16* RG = (bf16*)(F.ws + WS_H); bf16* SB = (bf16*)(F.ws + WS_SB);
      const size_t gt = (size_t)blockIdx.x * 512 + F.tid, NGT = (size_t)F.G * 512;
      for (size_t i = gt; i < (size_t)MTOK * DM; i += NGT) RG[i] = GR[i];
      for (size_t i = gt; i < (size_t)MTOK * 512; i += NGT) SB[i] = QS[i];
      return; }
#endif
    for (int bh = blockIdx.x; bh < 64; bh += F.G) naive_retention(F, bh);
    __syncthreads();
    const int gw = blockIdx.x * NWAVES + F.wave, NGW = F.G * NWAVES;
    for (int ri = gw; ri < 64 * SEQ; ri += NGW) naive_sb_row(F, ri);
    __syncthreads();
}

typedef float f32x16 __attribute__((ext_vector_type(16)));
typedef float f32x2c __attribute__((ext_vector_type(2))); typedef __bf16 bf16x2c __attribute__((ext_vector_type(2)));
typedef unsigned u32x2 __attribute__((ext_vector_type(2)));
__device__ __forceinline__ unsigned cvtpk(float lo, float hi) { f32x2c v = {lo, hi}; bf16x2c b = __builtin_convertvector(v, bf16x2c); return __builtin_bit_cast(unsigned, b); }
template <int S> __device__ __forceinline__ bf16x8 pack8(const f32x16& v) {
    v4u w; w.x = cvtpk(v[8 * S + 0], v[8 * S + 1]); w.y = cvtpk(v[8 * S + 2], v[8 * S + 3]); w.z = cvtpk(v[8 * S + 4], v[8 * S + 5]); w.w = cvtpk(v[8 * S + 6], v[8 * S + 7]);
    return __builtin_bit_cast(bf16x8, w);
}
#define MFMA32(a, b, c) __builtin_amdgcn_mfma_f32_32x32x16_bf16((a), (b), (c), 0, 0, 0)
__device__ __forceinline__ int pi32(int r) { return (r & ~12) | (((r >> 2) & 1) << 3) | (((r >> 3) & 1) << 2); }
#define RBAR() asm volatile("s_waitcnt lgkmcnt(0)\n\ts_barrier" ::: "memory")
#ifndef SB_EARLY
#define SB_EARLY 1
#endif
constexpr float SB_EXIT = 160.0f;

template <bool DIAG> __device__ __forceinline__ void sb_tile(const bf16* kp, const bf16* vp, const bf16x8 (&qf)[4], f32x16& O0, f32x16& O1, float& R, int c, int hi) {
    bf16x8 kf[4], vf[2][2];
#pragma unroll
    for (int ds = 0; ds < 4; ++ds) kf[ds] = *(const bf16x8*)(kp + 16 * ds);
#pragma unroll
    for (int dt = 0; dt < 2; ++dt)
#pragma unroll
        for (int s = 0; s < 2; ++s) vf[dt][s] = *(const bf16x8*)(vp + (size_t)dt * 32 * MTOK + 16 * s);
    f32x16 z = {0.f, 0.f, 0.f, 0.f, 0.f, 0.f, 0.f, 0.f, 0.f, 0.f, 0.f, 0.f, 0.f, 0.f, 0.f, 0.f};
#pragma unroll
    for (int ds = 0; ds < 4; ++ds) z = MFMA32(kf[ds], qf[ds], z);
    const int thr = c - 8 * hi;
    f32x16 sp, ls;
#pragma unroll
    for (int g = 0; g < 16; ++g) {
        const float e = __builtin_amdgcn_exp2f(-__builtin_fabsf(z[g])), l = __builtin_amdgcn_logf(1.0f + e);
        const float s = __builtin_fmaxf(z[g], 0.f) + l;
        ls[g] = z[g] - s;
        sp[g] = (DIAG && !((16 * (g >> 3) + (g & 7)) < thr)) ? 0.f : s;
    }
    f32x16 ex;
    ex[7] = 0.f; ex[15] = 0.f;
#pragma unroll
    for (int g = 6; g >= 0; --g) { ex[g] = ex[g + 1] + sp[g + 1]; ex[8 + g] = ex[8 + g + 1] + sp[8 + g + 1]; }
    const float Tlo = ex[0] + sp[0], Thi = ex[8] + sp[8];
    const float oTlo = __shfl_xor(Tlo, 32), oThi = __shfl_xor(Thi, 32);
    const float blo = R + Thi + oThi + (hi ? 0.f : oTlo), bhi = R + (hi ? 0.f : oThi);
    f32x16 A;
#pragma unroll
    for (int g = 0; g < 16; ++g) {
        const float a = __builtin_amdgcn_exp2f(ls[g] - ex[g] - (g < 8 ? blo : bhi));
        A[g] = (DIAG && !((16 * (g >> 3) + (g & 7)) < thr)) ? 0.f : a;
    }
    R += (Tlo + Thi) + (oTlo + oThi);
    const bf16x8 p0 = pack8<0>(A), p1 = pack8<1>(A);
    O0 = MFMA32(vf[0][0], p0, O0); O0 = MFMA32(vf[0][1], p1, O0);
    O1 = MFMA32(vf[1][0], p0, O1); O1 = MFMA32(vf[1][1], p1, O1);
}
__device__ __forceinline__ void sb_unit(Frame& F, int bh, int qb) {
    const int lane = F.lane, c = lane & 31, hi = lane >> 5, b = bh >> 3, hh = bh & 7;
    const int t0 = qb * 256 + F.wave * 32;
    const size_t tokbase = (size_t)b * SEQ;
    const bf16* QS = (const bf16*)(F.ws + WS_QS); const bf16* KS = (const bf16*)(F.ws + WS_KS); const bf16* VST = (const bf16*)(F.ws + WS_VST); bf16* SB = (bf16*)(F.ws + WS_SB);
    bf16x8 qf[4];
#pragma unroll
    for (int ds = 0; ds < 4; ++ds) qf[ds] = *(const bf16x8*)(QS + (tokbase + t0 + c) * 512 + hh * 64 + 16 * ds + 8 * hi);
    const bf16* kbase = KS + (tokbase + pi32(c)) * 512 + hh * 64 + 8 * hi;
    const bf16* vbase = VST + (size_t)(hh * 64 + c) * MTOK + tokbase + 8 * hi;
    f32x16 O0 = {0.f, 0.f, 0.f, 0.f, 0.f, 0.f, 0.f, 0.f, 0.f, 0.f, 0.f, 0.f, 0.f, 0.f, 0.f, 0.f}, O1 = O0;
    float R = 0.f;
    sb_tile<true>(kbase + (size_t)t0 * 512, vbase + t0, qf, O0, O1, R, c, hi);
    for (int key0 = t0 - 32; key0 >= 0; key0 -= 32) {
        if (SB_EARLY && __all(R > SB_EXIT)) break;
        sb_tile<false>(kbase + (size_t)key0 * 512, vbase + key0, qf, O0, O1, R, c, hi);
    }
    bf16* op = SB + (tokbase + t0 + c) * 512 + hh * 64 + 4 * hi;
#pragma unroll
    for (int q = 0; q < 4; ++q) {
        u32x2 w0; w0.x = cvtpk(O0[4 * q], O0[4 * q + 1]); w0.y = cvtpk(O0[4 * q + 2], O0[4 * q + 3]);
        u32x2 w1; w1.x = cvtpk(O1[4 * q], O1[4 * q + 1]); w1.y = cvtpk(O1[4 * q + 2], O1[4 * q + 3]);
        *(u32x2*)(op + 8 * q) = w0; *(u32x2*)(op + 32 + 8 * q) = w1;
    }
}

__device__ __forceinline__ void ret_unit(Frame& F, int bh) {
    const int lane = F.lane, c = lane & 31, hi = lane >> 5, b = bh >> 3, hh = bh & 7, es = F.wave & 3, th = F.wave >> 2;
    const float lg = pg8::log2gamma(hh), g64 = __builtin_amdgcn_exp2f(lg * 64.0f);
    const int ii = 32 * th + c;
    const float lanef = __builtin_amdgcn_exp2f(lg * (float)(ii + 1));
    f32x16 fm0, fm1;
#pragma unroll
    for (int g = 0; g < 16; ++g) {
        const int j0 = 16 * (g >> 3) + 8 * hi + (g & 7), j1 = 32 + j0;
        const int d0 = ii > j0 ? ii - j0 : j0 - ii, d1 = ii > j1 ? ii - j1 : j1 - ii;
        fm0[g] = __builtin_amdgcn_exp2f(lg * (float)(d0 - ii - 1)); fm1[g] = __builtin_amdgcn_exp2f(lg * (float)(d1 - ii - 1));
    }
    const size_t tokbase = (size_t)b * SEQ;
    const bf16* qptr = (const bf16*)(F.ws + WS_QR) + (tokbase + 32 * th + c) * 512 + hh * 64 + 8 * hi;
    const bf16* kptr = (const bf16*)(F.ws + WS_KR) + (tokbase + pi32(c)) * 512 + hh * 64 + 8 * hi;
    const bf16* vptr = (const bf16*)(F.ws + WS_VRT) + (size_t)(hh * 128 + 32 * es + c) * MTOK + tokbase + 8 * hi;
    const bf16* ktptr = (const bf16*)(F.ws + WS_KRT) + (size_t)(hh * 64 + pi32(c)) * MTOK + tokbase + 8 * hi;
    const bf16* grptr = (const bf16*)(F.ws + WS_GR) + (tokbase + 32 * th + c) * DM + hh * 128 + 32 * es + 4 * hi;
    bf16* rgptr = (bf16*)(F.ws + WS_H) + (tokbase + 32 * th + c) * DM + hh * 128 + 32 * es + 4 * hi;
    f32x4 gn[4];
#pragma unroll
    for (int q = 0; q < 4; ++q) gn[q] = *(const f32x4*)(F.ret_gn_g + hh * 128 + 32 * es + 8 * q + 4 * hi);
    LAS float* st = (LAS float*)(F.lds);
    const f32x16 zero16 = {0.f, 0.f, 0.f, 0.f, 0.f, 0.f, 0.f, 0.f, 0.f, 0.f, 0.f, 0.f, 0.f, 0.f, 0.f, 0.f};
    f32x16 S0 = zero16, S1 = zero16;
    for (int n = 0; n < 32; ++n) {
        const size_t tok0 = (size_t)n * 64;
        bf16x8 qf[4], vf[4];
#pragma unroll
        for (int ds = 0; ds < 4; ++ds) qf[ds] = *(const bf16x8*)(qptr + tok0 * 512 + 16 * ds);
#pragma unroll
        for (int js = 0; js < 4; ++js) vf[js] = *(const bf16x8*)(vptr + tok0 + 16 * js);
        f32x16 P0 = zero16, P1 = zero16;
#pragma unroll
        for (int ds = 0; ds < 4; ++ds) {
            const bf16x8 k0 = *(const bf16x8*)(kptr + tok0 * 512 + 16 * ds), k1 = *(const bf16x8*)(kptr + (tok0 + 32) * 512 + 16 * ds);
            P0 = MFMA32(k0, qf[ds], P0); P1 = MFMA32(k1, qf[ds], P1);
        }
        P0 = P0 * fm0; P1 = P1 * fm1;
        f32x16 R = zero16;
        R = MFMA32(vf[0], pack8<0>(P0), R); R = MFMA32(vf[1], pack8<1>(P0), R);
        R = MFMA32(vf[2], pack8<0>(P1), R); R = MFMA32(vf[3], pack8<1>(P1), R);
        R = MFMA32(pack8<0>(S0), qf[0], R); R = MFMA32(pack8<1>(S0), qf[1], R);
        R = MFMA32(pack8<0>(S1), qf[2], R); R = MFMA32(pack8<1>(S1), qf[3], R);
        R = R * lanef;
        S0 = S0 * g64; S1 = S1 * g64;
#pragma unroll
        for (int js = 0; js < 4; ++js) {
            const bf16x8 a0 = *(const bf16x8*)(ktptr + tok0 + 16 * js), a1 = *(const bf16x8*)(ktptr + (size_t)32 * MTOK + tok0 + 16 * js);
            S0 = MFMA32(a0, vf[js], S0); S1 = MFMA32(a1, vf[js], S1);
        }
        float ps = 0.f;
#pragma unroll
        for (int g = 0; g < 16; ++g) ps += R[g];
        ps += __shfl_xor(ps, 32);
        if (hi == 0) st[(th * 4 + es) * 32 + c] = ps;
        RBAR();
        const float mu = ((st[(th * 4 + 0) * 32 + c] + st[(th * 4 + 1) * 32 + c]) + (st[(th * 4 + 2) * 32 + c] + st[(th * 4 + 3) * 32 + c])) * (1.0f / 128.0f);
        float pq = 0.f;
#pragma unroll
        for (int g = 0; g < 16; ++g) { R[g] -= mu; pq += R[g] * R[g]; }
        pq += __shfl_xor(pq, 32);
        if (hi == 0) st[256 + (th * 4 + es) * 32 + c] = pq;
        RBAR();
        const float var = ((st[256 + (th * 4 + 0) * 32 + c] + st[256 + (th * 4 + 1) * 32 + c]) + (st[256 + (th * 4 + 2) * 32 + c] + st[256 + (th * 4 + 3) * 32 + c])) * (1.0f / 128.0f);
        const float rstd = 1.0f / sqrtf(var + RMS_EPS);
#pragma unroll
        for (int q = 0; q < 4; ++q) {
            const u32x2 gw = *(const u32x2*)(grptr + tok0 * DM + 8 * q);
            const float o0 = R[4 * q + 0] * rstd * gn[q][0] * pg8::bflo(gw.x), o1 = R[4 * q + 1] * rstd * gn[q][1] * pg8::bfhi(gw.x);
            const float o2 = R[4 * q + 2] * rstd * gn[q][2] * pg8::bflo(gw.y), o3 = R[4 * q + 3] * rstd * gn[q][3] * pg8::bfhi(gw.y);
            u32x2 w; w.x = cvtpk(o0, o1); w.y = cvtpk(o2, o3);
            *(u32x2*)(rgptr + tok0 * DM + 8 * q) = w;
        }
    }
    RBAR();
}

__device__ __forceinline__ void p3_mixers(Frame& F) {
#if defined(NAIVE_RET)
    for (int bh = blockIdx.x; bh < 64; bh += F.G) naive_retention(F, bh);
    __syncthreads();
#endif
#if defined(NAIVE_SB)
    { const int gw = blockIdx.x * NWAVES + F.wave, NGW = F.G * NWAVES;
      for (int ri = gw; ri < 64 * SEQ; ri += NGW) naive_sb_row(F, ri); }
    __syncthreads();
#endif
    const int G = F.G, bid = blockIdx.x;
    const int nret = G > 128 ? 64 : 0;
#if !defined(NAIVE_RET)
    if (nret) { if (bid < nret) ret_unit(F, bid); }
    else for (int bh = bid; bh < 64; bh += G) ret_unit(F, bh);
#endif
#if !defined(NAIVE_SB)
    if (nret) { if (bid >= nret) for (int u = bid - nret; u < 512; u += G - nret) sb_unit(F, u >> 3, u & 7); }
    else for (int u = bid; u < 512; u += G) sb_unit(F, u >> 3, u & 7);
#endif
    __syncthreads();
}
struct Args { const void* in[16]; float* out; unsigned char* ws; int ph_lo, ph_hi, li, pad; };
__global__ void __launch_bounds__(NWAVES * 64, 2) skel_fwd(Args args) {
    extern __shared__ __attribute__((aligned(16))) unsigned char lds[];
    Frame F;
    F.lds = (LAS unsigned char*)lds;
    F.MISC = (volatile LAS unsigned*)(F.lds + MISC_OFF);
    F.tid = threadIdx.x; F.lane = F.tid & 63; F.wave = __builtin_amdgcn_readfirstlane(F.tid >> 6);
    F.G = gridDim.x;
    F.ws = args.ws; F.out = args.out; F.ctl = (gu32*)(args.ws + WS_CTL);
    F.x = (const float*)args.in[0]; F.c = (const float*)args.in[1]; F.positions = (const int*)args.in[2]; F.ada_w = (const float*)args.in[3]; F.ada_b = (const float*)args.in[4];
    F.pre_mix_g = (const float*)args.in[5]; F.post_mix_g = (const float*)args.in[6]; F.pre_ffn_g = (const float*)args.in[7]; F.post_ffn_g = (const float*)args.in[8];
    F.w_in = (const float*)args.in[9]; F.ret_gn_g = (const float*)args.in[10]; F.w_ret = (const float*)args.in[11]; F.w_sb = (const float*)args.in[12]; F.w_out = (const float*)args.in[13];
    F.w_ff1 = (const float*)args.in[14]; F.w_ff2 = (const float*)args.in[15];
    unsigned char* ws = args.ws;
    for (int u = F.tid; u < (LDS_BYTES - LDSCTL_OFF) / 4; u += NWAVES * 64) ((LAS unsigned*)(F.lds + LDSCTL_OFF))[u] = 0u;
    __syncthreads();
    XcdBarrier bar; bar.bar = (unsigned*)(F.ctl + CW_BAR); bar.x = 0; bar.st = nullptr;
    if (N_LAUNCHES != NPH) bar = xcd_barrier_post((unsigned*)(F.ctl + CW_BAR), F.MISC + 8);
#define GRID_BAR() do { if (N_LAUNCHES != NPH) xcd_barrier(bar); } while (0)
    const int lo = args.ph_lo, hi = args.ph_hi;
#define IN(k) (lo <= (k) && (k) < hi)
#define BOTH(k) (IN(k) && IN((k) + 1))
    bf16* H = (bf16*)(ws + WS_H);
    if (IN(0)) { p0_prologue(F); if (BOTH(0)) GRID_BAR(); }
    if (IN(1)) { p1_rows(F); if (BOTH(1)) GRID_BAR(); }
    if (IN(2)) {
        {   pg8::Gemm g{H, (const bf16*)(ws + WS_WNAT), MTOK, 5120, DM}; pg8::StaticOrder S; S.init(MTOK, 5120, F.G, (int)blockIdx.x);
            pg8::EpiProjNat E{(bf16*)(ws + WS_QR), (bf16*)(ws + WS_KR), (bf16*)(ws + WS_QS), (bf16*)(ws + WS_KS), (bf16*)(ws + WS_GR), (bf16*)F.out, (bf16*)F.out + (size_t)MTOK * DM, (const float*)(ws + WS_CS)};
            pg8::gemm_phase<pg8::EpiProjNat, pg8::StaticOrder, true, true>(F.lds + RING_OFF, g, S, E); }
        {   pg8::Gemm g{(const bf16*)(ws + WS_WTR), H, 2048, MTOK, DM}; pg8::StaticOrder S; S.init(2048, MTOK, F.G, (int)blockIdx.x);
            pg8::EpiProjTr E{(bf16*)(ws + WS_KRT), (bf16*)(ws + WS_VRT), (bf16*)(ws + WS_VST), (const float*)(ws + WS_CST)};
            pg8::gemm_phase<pg8::EpiProjTr, pg8::StaticOrder, true, true>(F.lds + RING_OFF, g, S, E); }
        if (BOTH(2)) GRID_BAR();
    }
    if (IN(3)) { p3_mixers(F); if (BOTH(3)) GRID_BAR(); }
    if (IN(4)) {
        {   pg8::Gemm g{H  , (const bf16*)(ws + WS_WRET), MTOK, DM, DM}; pg8::StaticOrder S; S.init(MTOK, DM, F.G, (int)blockIdx.x);
            pg8::EpiMerge<false> E{(const bf16*)F.out, nullptr, (bf16*)(ws + WS_T)};
            pg8::gemm_phase<pg8::EpiMerge<false>, pg8::StaticOrder, true, true>(F.lds + RING_OFF, g, S, E); }
        asm volatile("s_waitcnt vmcnt(0)" ::: "memory"); __syncthreads();
        {   pg8::Gemm g{(const bf16*)(ws + WS_SB), (const bf16*)(ws + WS_WSB), MTOK, DM, 512}; pg8::StaticOrder S; S.init(MTOK, DM, F.G, (int)blockIdx.x);
            pg8::EpiMerge<true> E{(const bf16*)F.out + (size_t)MTOK * DM, (const bf16*)(ws + WS_T), (bf16*)(ws + WS_MIX)};
            pg8::gemm_phase<pg8::EpiMerge<true>, pg8::StaticOrder, true, true>(F.lds + RING_OFF, g, S, E); }
        if (BOTH(4)) GRID_BAR();
    }
    if (IN(5)) {
        pg8::Gemm g{(const bf16*)(ws + WS_MIX), (const bf16*)(ws + WS_WOUT), MTOK, DM, DM}; pg8::StaticOrder S; S.init(MTOK, DM, F.G, (int)blockIdx.x);
        pg8::EpiF32 E{(float*)(ws + WS_Y), DM};
        pg8::gemm_phase<pg8::EpiF32, pg8::StaticOrder, true, true>(F.lds + RING_OFF, g, S, E);
        if (BOTH(5)) GRID_BAR();
    }
    if (IN(6)) { p6_rows(F); if (BOTH(6)) GRID_BAR(); }
    if (IN(7)) {
        pg8::Gemm g{H  , (const bf16*)(ws + WS_WFF1), MTOK, DFF, DM}; pg8::StaticOrder S; S.init(MTOK, DFF, F.G, (int)blockIdx.x);
        pg8::EpiBf<1> E{(bf16*)(ws + WS_U), DFF};
        pg8::gemm_phase<pg8::EpiBf<1>, pg8::StaticOrder, true, true>(F.lds + RING_OFF, g, S, E);
        if (BOTH(7)) GRID_BAR();
    }
    if (IN(8)) {
        pg8::Gemm g{(const bf16*)(ws + WS_U), (const bf16*)(ws + WS_WFF2), MTOK, DM, DFF}; pg8::StaticOrder S; S.init(MTOK, DM, F.G, (int)blockIdx.x);
        pg8::EpiBf<0> E{(bf16*)(ws + WS_F), DM};
        pg8::gemm_phase<pg8::EpiBf<0>, pg8::StaticOrder, true, true>(F.lds + RING_OFF, g, S, E);
        if (BOTH(8)) GRID_BAR();
    }
    if (IN(9)) { p9_rows(F); }
#ifdef PROBE_STOP
    {   const size_t gt = (size_t)blockIdx.x * 512 + F.tid, NGT = (size_t)F.G * 512;
        float* dig = (float*)(ws + WS_SB);
        const size_t N4 = (size_t)4 << 20;
        if (IN(10)) {
            const bf16* a = (const bf16*)F.out;
            for (size_t j = gt; j < N4; j += NGT) { float v = 0.f; for (int q = 0; q < 8; ++q) v += bf2f(a[j + q * N4]); dig[j] = v; }
        }
        if (IN(11)) {
            const bf16* Hh = (const bf16*)(ws + WS_H); const bf16* Wall = (const bf16*)(ws + WS_WNAT); const float* cs = (const float*)(ws + WS_CS); const float* mod = (const float*)(ws + WS_MOD);
            const bf16* act = (const bf16*)(ws + WS_QR);
            const size_t NW = (size_t)35 << 19;
            for (size_t i = gt; i < (size_t)MTOK * DM; i += NGT) {
                float v = bf2f(Hh[i]) + bf2f(Wall[i % NW]) + bf2f(Wall[(i + ((size_t)16 << 20)) % NW]) + cs[i % ((size_t)2 << 20)] + mod[i % 49152];
#if PROBE_STOP >= 2
                for (int q = 0; q < 5; ++q) v += bf2f(act[i + q * ((size_t)16 << 20)]);
                v += dig[i % N4];
#endif
                F.out[i] = v;
            }
        }
    }
#endif
#undef IN
#undef BOTH
}

extern "C" void kernel_launch(void* const* d_in, const int* in_sizes, int n_in, void* d_out, int out_size, void* d_ws, size_t ws_size, hipStream_t stream) {
    static int grid = 0;
    if (grid == 0) {
        if (n_in != 16 || out_size != MTOK * DM || ws_size < WS_END) { fprintf(stderr, "kernel_launch: unexpected shapes (n_in %d out %d ws %zu)\n", n_in, out_size, ws_size); grid = -1; return; }
        int dev = 0, cus = 0;
        if (hipGetDevice(&dev) != hipSuccess || hipDeviceGetAttribute(&cus, hipDeviceAttributeMultiprocessorCount, dev) != hipSuccess) { grid = -1; return; }
        if (hipFuncSetAttribute((const void*)skel_fwd, hipFuncAttributeMaxDynamicSharedMemorySize, LDS_BYTES) != hipSuccess) { fprintf(stderr, "kernel_launch: hipFuncSetAttribute failed\n"); grid = -1; return; }
        (void)hipGetLastError();
        grid = cus;
    }
    if (grid < 0) return;
    if (hipMemsetAsync((char*)d_ws + WS_CTL, 0, CTL_ZERO_BYTES, stream) != hipSuccess) return;
    Args a{};
    for (int i = 0; i < 16; ++i) a.in[i] = d_in[i];
    a.out = (float*)d_out; a.ws = (unsigned char*)d_ws;
#ifdef PROBE_STOP
    for (int li = 0; li < 12; ++li) {
        if (li > PROBE_STOP && li < 10) continue;
        if (li == 10 && PROBE_STOP < 2) continue;
        a.ph_lo = li; a.ph_hi = li + 1; a.li = li;
        hipLaunchKernelGGL(skel_fwd, dim3(grid), dim3(NWAVES * 64), LDS_BYTES, stream, a);
    }
#else
    for (int li = 0; li < N_LAUNCHES; ++li) {
        if (N_LAUNCHES == NPH) { a.ph_lo = li; a.ph_hi = li + 1; } else { a.ph_lo = 0; a.ph_hi = NPH; }
        a.li = li;
        hipLaunchKernelGGL(skel_fwd, dim3(grid), dim3(NWAVES * 64), LDS_BYTES, stream, a);
    }
#endif
}
```
